# Optimizing an MI355X kernel written in HIP

```python
import math
import jax, jax.numpy as jnp
from jax import lax
import numpy as np

D_MODEL = 1024
BATCH = 8
SEQ = 4096
DEPTH = 1

HG_HEADS = 4
HG_KDIM = 128
HG_VDIM = 128
HG_WIDTH = HG_HEADS * HG_KDIM
CHUNK = 32
LRU_WIDTH = 512
LRU_BLOCKS = 8
LRU_BLOCK_DIM = LRU_WIDTH // LRU_BLOCKS
CONV_WIDTH = 4
LRU_C = 8.0
D_MIX = HG_WIDTH + LRU_WIDTH
D_IN = 4 * HG_WIDTH + 2 * LRU_WIDTH
D_FF = -(-8 * D_MODEL // (3 * 256)) * 256
EPS = 1e-6

kernel_name = 'hybrid_hgrn2_rglru_parallel_heads'


def rms_norm(x, w):
    xf = x.astype(jnp.float32)
    y = xf * lax.rsqrt(jnp.mean(xf * xf, axis=-1, keepdims=True) + EPS)
    return (y * w.astype(jnp.float32)).astype(x.dtype)


def hgrn2_mix(q, f_logit, i, g, lb, norm_w):
    B, S, _ = q.shape
    out_dtype = q.dtype
    qf = jax.nn.silu(q.astype(jnp.float32))
    f = lb + (1.0 - lb) * jax.nn.sigmoid(f_logit.astype(jnp.float32))
    log_f = jnp.log(f)
    k = 1.0 - f
    v = i.astype(jnp.float32)
    n_chunks = S // CHUNK

    def to_chunks(t, d):
        return t.reshape(B, n_chunks, CHUNK, HG_HEADS, d).transpose(1, 0, 3, 2, 4)

    qc, kc, gc, vc = to_chunks(qf, HG_KDIM), to_chunks(k, HG_KDIM), to_chunks(log_f, HG_KDIM), to_chunks(v, HG_VDIM)
    causal = jnp.tril(jnp.ones((CHUNK, CHUNK), dtype=bool))

    def step(state, xs):
        q_, k_, lg, v_ = xs
        b = jnp.cumsum(lg, axis=-2)
        b_last = b[..., -1:, :]
        q_dec = q_ * jnp.exp(b)
        k_dec = k_ * jnp.exp(-b)
        scores = jnp.where(causal, jnp.einsum('bhtk,bhsk->bhts', q_dec, k_dec), 0.0)
        o = jnp.einsum('bhts,bhsv->bhtv', scores, v_) + jnp.einsum('bhtk,bhkv->bhtv', q_dec, state)
        k_state = k_ * jnp.exp(b_last - b)
        new_state = jnp.exp(b_last)[..., 0, :, None] * state + jnp.einsum('bhsk,bhsv->bhkv', k_state, v_)
        return new_state, o

    state0 = jnp.zeros((B, HG_HEADS, HG_KDIM, HG_VDIM), jnp.float32)
    _, o = lax.scan(step, state0, (qc, kc, gc, vc))
    o = o.transpose(1, 0, 3, 2, 4).reshape(B, S, HG_HEADS, HG_VDIM)
    o = o * lax.rsqrt(jnp.mean(o * o, axis=-1, keepdims=True) + EPS) * norm_w.astype(jnp.float32)
    o = o * jax.nn.silu(g.astype(jnp.float32).reshape(B, S, HG_HEADS, HG_VDIM))
    return o.reshape(B, S, HG_WIDTH).astype(out_dtype)


def rglru_mix(xb, gate_b, conv_w, conv_b, wa, ba, wx, bx, a_param):
    B, S, W = xb.shape
    out_dtype = xb.dtype
    x_pad = jnp.pad(xb, ((0, 0), (CONV_WIDTH - 1, 0), (0, 0)))
    xc = conv_b + sum(x_pad[:, tap:tap + S] * conv_w[tap] for tap in range(CONV_WIDTH))
    xc = xc.astype(jnp.float32)
    xblk = xc.reshape(B, S, LRU_BLOCKS, LRU_BLOCK_DIM)
    r = jax.nn.sigmoid(jnp.einsum('bsnd,nde->bsne', xblk, wa.astype(jnp.float32)).reshape(B, S, W) + ba)
    ig = jax.nn.sigmoid(jnp.einsum('bsnd,nde->bsne', xblk, wx.astype(jnp.float32)).reshape(B, S, W) + bx)
    log_a = -LRU_C * r * jax.nn.softplus(-a_param.astype(jnp.float32))
    a = jnp.exp(log_a)
    b_in = jnp.sqrt(-jnp.expm1(2.0 * log_a)) * (ig * xc)

    def combine(lhs, rhs):
        a1, b1 = lhs
        a2, b2 = rhs
        return a1 * a2, a2 * b1 + b2

    _, h = lax.associative_scan(combine, (a, b_in), axis=1)
    y = h * jax.nn.gelu(gate_b.astype(jnp.float32), approximate=True)
    return y.astype(out_dtype)


def setup_inputs(seed: int = 0) -> dict:
    key = jax.random.key(seed)
    ks = jax.random.split(key, 20)
    f32 = jnp.float32
    nrm = lambda k, shape, scale: (jax.random.normal(k, shape, f32) * scale)
    s_lru = jax.random.uniform(ks[12], (DEPTH, LRU_WIDTH), f32, 0.9, 0.999) ** (1.0 / LRU_C)
    return {
        'x': nrm(ks[0], (BATCH, SEQ, D_MODEL), 1.0),
        'mix_norm_w': 1.0 + nrm(ks[1], (DEPTH, D_MODEL), 0.02),
        'w_in': nrm(ks[2], (DEPTH, D_MODEL, D_IN), D_MODEL ** -0.5),
        'hg_lb': nrm(ks[3], (DEPTH + 1, HG_WIDTH), 0.5),
        'hg_norm_w': 1.0 + nrm(ks[4], (DEPTH, HG_VDIM), 0.02),
        'conv_w': nrm(ks[5], (DEPTH, CONV_WIDTH, LRU_WIDTH), CONV_WIDTH ** -0.5),
        'conv_b': nrm(ks[6], (DEPTH, LRU_WIDTH), 0.02),
        'lru_wa': nrm(ks[7], (DEPTH, LRU_BLOCKS, LRU_BLOCK_DIM, LRU_BLOCK_DIM), LRU_BLOCK_DIM ** -0.5),
        'lru_ba': nrm(ks[8], (DEPTH, LRU_WIDTH), 0.02),
        'lru_wx': nrm(ks[9], (DEPTH, LRU_BLOCKS, LRU_BLOCK_DIM, LRU_BLOCK_DIM), LRU_BLOCK_DIM ** -0.5),
        'lru_bx': nrm(ks[10], (DEPTH, LRU_WIDTH), 0.02),
        'lru_a': jnp.log(s_lru) - jnp.log1p(-s_lru),
        'w_out': nrm(ks[11], (DEPTH, D_MIX, D_MODEL), D_MIX ** -0.5),
        'ffn_norm_w': 1.0 + nrm(ks[13], (DEPTH, D_MODEL), 0.02),
        'w_gate_up': nrm(ks[14], (DEPTH, D_MODEL, 2 * D_FF), D_MODEL ** -0.5),
        'w_down': nrm(ks[15], (DEPTH, D_FF, D_MODEL), D_FF ** -0.5),
        'final_norm_w': 1.0 + nrm(ks[16], (D_MODEL,), 0.02),
    }


def reference(x, mix_norm_w, w_in, hg_lb, hg_norm_w, conv_w, conv_b, lru_wa, lru_ba,
              lru_wx, lru_bx, lru_a, w_out, ffn_norm_w, w_gate_up, w_down, final_norm_w):
    lb_all = jnp.cumsum(jax.nn.softmax(hg_lb.astype(jnp.float32), axis=0), axis=0)
    h = x
    for l in range(DEPTH):
        xn = rms_norm(h, mix_norm_w[l])
        proj = jnp.einsum('bsd,de->bse', xn, w_in[l])
        q, f_logit, i_v, g, lru_x, lru_gate = jnp.split(
            proj, [HG_WIDTH, 2 * HG_WIDTH, 3 * HG_WIDTH, 4 * HG_WIDTH, 4 * HG_WIDTH + LRU_WIDTH], axis=-1)
        o_hg = hgrn2_mix(q, f_logit, i_v, g, lb_all[l], hg_norm_w[l])
        o_lru = rglru_mix(lru_x, lru_gate, conv_w[l], conv_b[l], lru_wa[l], lru_ba[l],
                          lru_wx[l], lru_bx[l], lru_a[l])
        mixed = jnp.concatenate([o_hg, o_lru], axis=-1)
        h = h + jnp.einsum('bse,ed->bsd', mixed, w_out[l])
        hn = rms_norm(h, ffn_norm_w[l])
        gate, up = jnp.split(jnp.einsum('bsd,df->bsf', hn, w_gate_up[l]), 2, axis=-1)
        h = h + jnp.einsum('bsf,fd->bsd', jax.nn.silu(gate) * up, w_down[l])
    return rms_norm(h, final_norm_w)
```

```cpp
#include <hip/hip_runtime.h>
#include <hip/hip_cooperative_groups.h>
#include <cstdio>
#include <cstdint>
namespace cg = cooperative_groups;

#define LAS __attribute__((address_space(3)))
#define DI __device__ __forceinline__
typedef unsigned short bf16_t;
typedef short bf16x8 __attribute__((ext_vector_type(8)));
typedef float f32x4 __attribute__((ext_vector_type(4)));
typedef float f32x2 __attribute__((ext_vector_type(2)));
typedef unsigned u32x4 __attribute__((ext_vector_type(4)));
typedef unsigned u32x2 __attribute__((ext_vector_type(2)));

#ifndef MK_N_LAUNCHES
#define MK_N_LAUNCHES 1
#endif

constexpr int BATCH = 8, SEQ = 4096, DM = 1024, M = BATCH * SEQ;
constexpr int DIN = 3072, DFF = 2816, NGU = 2 * DFF;
constexpr float EPS = 1e-6f;
constexpr int NPH = 8;

constexpr size_t MiB = 1u << 20;
constexpr size_t WS_PART1 = 1 * MiB;
constexpr size_t WS_PART2 = 3 * MiB;
constexpr size_t WS_BL = 5 * MiB;
constexpr size_t WS_LRT = 7 * MiB;
constexpr size_t WS_BLS = 7 * MiB + 512 * 1024;
constexpr size_t WS_WIN = 8 * MiB, WS_WOUT = 14 * MiB, WS_WGU = 16 * MiB, WS_WDN = 27 * MiB;
constexpr size_t WS_SA = 34 * MiB;
constexpr size_t WS_XN = 50 * MiB;
constexpr size_t WS_MIXED = 114 * MiB;
constexpr size_t WS_ACT = 50 * MiB;
constexpr size_t WS_QD = 226 * MiB, WS_KD = 258 * MiB, WS_KS = 290 * MiB, WS_VV = 322 * MiB, WS_GS = 354 * MiB, WS_LX = 386 * MiB, WS_LG = 418 * MiB;
constexpr size_t WS_H1 = 226 * MiB;
constexpr size_t WS_H1B = 354 * MiB;
constexpr size_t WS_END = 450 * MiB;

constexpr int LDS_BYTES = 147456;

typedef __bf16 bf16x2v __attribute__((ext_vector_type(2)));
DI unsigned cvt_pk_bf16(float lo, float hi) { f32x2 v = {lo, hi}; bf16x2v b = __builtin_convertvector(v, bf16x2v); return __builtin_bit_cast(unsigned, b); }
DI float bf2f(unsigned short h) { return __builtin_bit_cast(float, (unsigned)h << 16); }
DI float bflo(unsigned w) { return __builtin_bit_cast(float, w << 16); }
DI float bfhi(unsigned w) { return __builtin_bit_cast(float, w & 0xffff0000u); }
DI float fexp(float x) { return __expf(x); }
DI float frcp(float x) { return __builtin_amdgcn_rcpf(x); }
DI float sigm(float x) { return frcp(1.f + fexp(-x)); }
DI float wave_sum(float v) {
#pragma unroll
    for (int o = 1; o < 64; o <<= 1) v += __shfl_xor(v, o);
    return v;
}
template <int D_> DI float dpp_shr(float v) { return __builtin_bit_cast(float, __builtin_amdgcn_update_dpp(0, __builtin_bit_cast(int, v), 0x110 + D_, 0xf, 0xf, true)); }
DI float scan16(float v) { v += dpp_shr<1>(v); v += dpp_shr<2>(v); v += dpp_shr<4>(v); v += dpp_shr<8>(v); return v; }
DI float row_last(float v) { return __shfl(v, 15, 16); }

namespace pg8 {
constexpr int BM = 256, BK = 64, HALF = 128, HTB = HALF * BK * 2, STAGE_BYTES = 8 * HTB, NXCD = 8, WGM = 8;
__host__ __device__ __forceinline__ int lds_byte(int r, int c) { const int st = (r >> 4) * 2 + (c >> 5), rr = r & 15, cc = c & 31, ob = rr * 64 + cc * 2; return st * 1024 + (ob ^ (((ob >> 9) & 1) << 5)); }
__host__ __device__ __forceinline__ void stage_rc(int b, int& R, int& C) { const int st = b / 1024, sb = b % 1024, swz = sb ^ (((sb >> 9) & 1) << 5); R = (st >> 1) * 16 + swz / 64; C = (st & 1) * 32 + (swz % 64) / 2; }
__host__ __device__ __forceinline__ int perm32(int rho) { const int n = rho >> 4, i = rho & 15; return 8 * (i >> 2) + 4 * n + (i & 3); }
struct Unit { int pm, pn; };
struct Gemm { const bf16_t* A; const bf16_t* Bt; int M, N, K; };
struct StaticOrder {
    int nM, nN, nwg, G, c;
    __host__ __device__ void init(int M_, int N_, int G_, int c_) { nM = M_ / BM; nN = N_ / BM; nwg = nM * nN; G = G_; c = c_; }
    __host__ __device__ bool next(int i, Unit& u) const {
        const long L = (long)i * G + c; if (L >= nwg) return false;
        int wgid = (int)L; { const int q = nwg / NXCD, r = nwg % NXCD, xcd = wgid % NXCD, off = wgid / NXCD; wgid = (xcd < r ? xcd * (q + 1) : r * (q + 1) + (xcd - r) * q) + off; }
        const int nig = WGM * nN, gid = wgid / nig, fm = gid * WGM, gsz = (nM - fm) < WGM ? (nM - fm) : WGM;
        u.pm = fm + ((wgid % nig) % gsz); u.pn = (wgid % nig) / gsz; return true;
    }
};

template <class Epi, bool ALIGN_EPI>
__device__ __forceinline__ void gemm_phase(LAS unsigned char* lds, const Gemm g, const StaticOrder& S, const Epi& E) {
    const int tid = threadIdx.x, wid = __builtin_amdgcn_readfirstlane(tid >> 6), lane = tid & 63, wr = wid >> 2, wc = wid & 3, fr = lane & 15, fq = lane >> 4;
    const int K = g.K, nt = K / BK;
    unsigned voffA[2], voffB[2];
#pragma unroll
    for (int i = 0; i < 2; ++i) { int R, C; stage_rc(tid * 16 + i * 8192, R, C); const int Rb = Epi::PERM ? ((R & ~31) + perm32(R & 31)) : R;
        voffA[i] = (unsigned)(R * K + C) * 2u; voffB[i] = (unsigned)(Rb * K + C) * 2u; }
    const size_t kstep = (size_t)(BK * 2);
    const size_t hstep = (size_t)HALF * K * 2;
    const size_t tstep = 2 * hstep;
    const unsigned ldsw = (unsigned)wid * 1024u;
    const int aoff = lds_byte(wr * 64 + fr, fq * 8), boff = lds_byte(wc * 32 + fr, fq * 8);
#define PG8_SA(b, h) (((b) * 2 + (h)) * HTB)
#define PG8_SB(b, h) ((4 + (b) * 2 + (h)) * HTB)
#define PG8_STAGE(bufoff, gbase, voff) do { _Pragma("unroll") for (int _i = 0; _i < 2; ++_i) \
        __builtin_amdgcn_global_load_lds((const unsigned*)((const char*)(gbase) + (voff)[_i]), (LAS unsigned*)(lds + (bufoff) + ldsw + _i * 8192), 16, 0, 0); } while (0)
#define PG8_LDA(dst, b, h) do { _Pragma("unroll") for (int m = 0; m < 4; ++m) _Pragma("unroll") for (int k = 0; k < 2; ++k) dst[m][k] = *(const LAS bf16x8*)(lds + PG8_SA(b, h) + aoff + m * 2048 + k * 1024); } while (0)
#define PG8_LDB(dst, b, h) do { _Pragma("unroll") for (int n = 0; n < 2; ++n) _Pragma("unroll") for (int k = 0; k < 2; ++k) dst[n][k] = *(const LAS bf16x8*)(lds + PG8_SB(b, h) + boff + n * 2048 + k * 1024); } while (0)
#define PG8_MMA(ai, bj, At, Bt) do { __builtin_amdgcn_s_setprio(1); _Pragma("unroll") for (int m = 0; m < 4; ++m) _Pragma("unroll") for (int n = 0; n < 2; ++n) _Pragma("unroll") for (int k = 0; k < 2; ++k) \
        acc[ai][bj][m][n] = __builtin_amdgcn_mfma_f32_16x16x32_bf16(Bt[n][k], At[m][k], acc[ai][bj][m][n], 0, 0, 0); __builtin_amdgcn_s_setprio(0); } while (0)
#define PG8_WAIT_V(n) asm volatile("s_waitcnt vmcnt(" #n ")" ::: "memory")
#define PG8_WAIT_L(n) asm volatile("s_waitcnt lgkmcnt(" #n ")" ::: "memory")
#define PG8_BAR __builtin_amdgcn_s_barrier()
#define PG8_SCHED __builtin_amdgcn_sched_barrier(0)
    Unit cur, nxt; int ui = 0;
    if (!S.next(0, cur)) return;
    f32x4 acc[2][2][4][2];
#pragma unroll
    for (int a = 0; a < 2; ++a)
#pragma unroll
        for (int b = 0; b < 2; ++b)
#pragma unroll
            for (int m = 0; m < 4; ++m)
#pragma unroll
                for (int n = 0; n < 2; ++n) acc[a][b][m][n] = (f32x4){0.f, 0.f, 0.f, 0.f};
    bf16x8 At[4][2], B0[2][2], B1[2][2];
    const char* cA = (const char*)g.A + (size_t)cur.pm * tstep; const char* cB = (const char*)g.Bt + (size_t)cur.pn * tstep;
    PG8_STAGE(PG8_SB(0, 0), cB, voffB); PG8_STAGE(PG8_SB(0, 1), cB + hstep, voffB); PG8_STAGE(PG8_SA(0, 0), cA, voffA); PG8_STAGE(PG8_SA(0, 1), cA + hstep, voffA);
    if (wr == 1) PG8_BAR;
    PG8_WAIT_V(2); PG8_BAR;
    PG8_STAGE(PG8_SB(1, 0), cB + kstep, voffB); PG8_STAGE(PG8_SA(1, 0), cA + kstep, voffA); PG8_STAGE(PG8_SB(1, 1), cB + hstep + kstep, voffB);
    PG8_WAIT_V(6); PG8_BAR;
    for (;;) {
        const bool has_next = S.next(ui + 1, nxt);
        const char* nA = has_next ? (const char*)g.A + (size_t)nxt.pm * tstep : cA; const char* nB = has_next ? (const char*)g.Bt + (size_t)nxt.pn * tstep : cB;
        for (int t = 0; t < nt; t += 2) {
            const bool last = (t == nt - 2);
            const char* a1 = cA + (size_t)(t + 1) * kstep;
            const char* a2 = last ? nA : cA + (size_t)(t + 2) * kstep; const char* b2 = last ? nB : cB + (size_t)(t + 2) * kstep;
            const char* a3 = a2 + kstep; const char* b3 = b2 + kstep;
            PG8_LDB(B0, 0, 0); PG8_LDB(B1, 0, 1); PG8_SCHED; PG8_LDA(At, 0, 0); PG8_STAGE(PG8_SA(1, 1), a1 + hstep, voffA);
            PG8_WAIT_V(8); PG8_WAIT_L(0); PG8_BAR; PG8_MMA(0, 0, At, B0); PG8_MMA(0, 1, At, B1); PG8_BAR; PG8_SCHED;
            PG8_LDA(At, 0, 1); PG8_STAGE(PG8_SB(0, 0), b2, voffB); PG8_STAGE(PG8_SB(0, 1), b2 + hstep, voffB); PG8_STAGE(PG8_SA(0, 0), a2, voffA);
            PG8_WAIT_V(8); PG8_WAIT_L(0); PG8_BAR; PG8_MMA(1, 0, At, B0); PG8_MMA(1, 1, At, B1); PG8_BAR; PG8_SCHED;
            PG8_LDB(B0, 1, 0); PG8_LDB(B1, 1, 1); PG8_SCHED; PG8_LDA(At, 1, 0); PG8_STAGE(PG8_SA(0, 1), a2 + hstep, voffA);
            PG8_WAIT_V(8); PG8_WAIT_L(0); PG8_BAR; PG8_MMA(0, 0, At, B0); PG8_MMA(0, 1, At, B1); PG8_BAR; PG8_SCHED;
            PG8_LDA(At, 1, 1); PG8_STAGE(PG8_SB(1, 0), b3, voffB); PG8_STAGE(PG8_SB(1, 1), b3 + hstep, voffB); PG8_STAGE(PG8_SA(1, 0), a3, voffA);
            PG8_WAIT_V(8); PG8_WAIT_L(0); PG8_BAR; PG8_MMA(1, 0, At, B0); PG8_MMA(1, 1, At, B1); PG8_BAR; PG8_SCHED;
        }
        if constexpr (ALIGN_EPI) { if (wr == 0) PG8_BAR; }
        E(acc, cur, wr, wc, fr, fq);
        if (!has_next) break;
#pragma unroll
        for (int a = 0; a < 2; ++a)
#pragma unroll
            for (int b = 0; b < 2; ++b)
#pragma unroll
                for (int m = 0; m < 4; ++m)
#pragma unroll
                    for (int n = 0; n < 2; ++n) acc[a][b][m][n] = (f32x4){0.f, 0.f, 0.f, 0.f};
        cur = nxt; cA = nA; cB = nB; ++ui;
        if constexpr (ALIGN_EPI) { if (wr == 1) PG8_BAR; }
    }
    PG8_WAIT_V(0);
    if constexpr (!ALIGN_EPI) { if (wr == 0) PG8_BAR; }
    PG8_BAR;
#undef PG8_SA
#undef PG8_SB
#undef PG8_STAGE
#undef PG8_LDA
#undef PG8_LDB
#undef PG8_MMA
#undef PG8_WAIT_V
#undef PG8_WAIT_L
#undef PG8_BAR
#undef PG8_SCHED
}
}

typedef f32x4 AccT[2][2][4][2];

struct EpiG1 {
    static constexpr bool PERM = true;
    bf16_t *QD, *KD, *KS, *VV, *GS, *LX, *LG; float* BL; const float* hg_lb;
    __device__ __forceinline__ void operator()(const AccT& acc, const pg8::Unit& u, int wr, int wc, int fr, int fq) const {
        const int row0 = u.pm * 256 + wr * 64 + fr;
        if (u.pn < 4) {
            const int h = u.pn, kc = h * 128 + wc * 32 + 8 * fq;
            float lbv[8], olb[8];
#pragma unroll
            for (int j = 0; j < 8; ++j) { const float a0 = hg_lb[kc + j], a1 = hg_lb[512 + kc + j]; lbv[j] = frcp(1.f + fexp(a1 - a0)); olb[j] = 1.f - lbv[j]; }
#pragma unroll
            for (int ai = 0; ai < 2; ++ai)
#pragma unroll
                for (int cp = 0; cp < 2; ++cp) {
                    unsigned qd[2][4], kd[2][4], ks[2][4]; float bl[8];
#pragma unroll
                    for (int n = 0; n < 2; ++n)
#pragma unroll
                        for (int e2 = 0; e2 < 2; ++e2) {
                            float oq[2][2], ok[2][2], os[2][2];
#pragma unroll
                            for (int ee = 0; ee < 2; ++ee) {
                                const int e = e2 * 2 + ee, j = 4 * n + e;
                                const float x0 = acc[ai][1][2 * cp][n][e], x1 = acc[ai][1][2 * cp + 1][n][e];
                                const float e0 = fexp(-x0), e1 = fexp(-x1), i0 = frcp(1.f + e0), i1 = frcp(1.f + e1);
                                const float f0 = lbv[j] + olb[j] * i0, f1 = lbv[j] + olb[j] * i1;
                                const float k0 = 1.f - f0, k1 = 1.f - f1;
                                const float p0 = scan16(__logf(f0)); const float t0 = row_last(p0);
                                const float p1 = scan16(__logf(f1)) + t0; const float bt = row_last(p1);
                                bl[j] = bt;
                                const float q0 = acc[ai][0][2 * cp][n][e], q1 = acc[ai][0][2 * cp + 1][n][e];
                                oq[0][ee] = q0 * sigm(q0) * fexp(p0); oq[1][ee] = q1 * sigm(q1) * fexp(p1);
                                ok[0][ee] = k0 * fexp(-p0); ok[1][ee] = k1 * fexp(-p1);
                                os[0][ee] = k0 * fexp(bt - p0); os[1][ee] = k1 * fexp(bt - p1);
                            }
#pragma unroll
                            for (int mm = 0; mm < 2; ++mm) { qd[mm][2 * n + e2] = cvt_pk_bf16(oq[mm][0], oq[mm][1]); kd[mm][2 * n + e2] = cvt_pk_bf16(ok[mm][0], ok[mm][1]); ks[mm][2 * n + e2] = cvt_pk_bf16(os[mm][0], os[mm][1]); }
                        }
#pragma unroll
                    for (int mm = 0; mm < 2; ++mm) {
                        const size_t off = (size_t)(row0 + ai * 128 + (2 * cp + mm) * 16) * 512 + kc;
                        *(u32x4*)(QD + off) = (u32x4){qd[mm][0], qd[mm][1], qd[mm][2], qd[mm][3]};
                        *(u32x4*)(KD + off) = (u32x4){kd[mm][0], kd[mm][1], kd[mm][2], kd[mm][3]};
                        *(u32x4*)(KS + off) = (u32x4){ks[mm][0], ks[mm][1], ks[mm][2], ks[mm][3]};
                    }
                    if (fr == 15) {
                        const int rc = (u.pm * 256 + ai * 128 + wr * 64 + cp * 32) >> 5;
                        float* bp = BL + (size_t)rc * 512 + kc;
                        *(f32x4*)bp = (f32x4){bl[0], bl[1], bl[2], bl[3]}; *(f32x4*)(bp + 4) = (f32x4){bl[4], bl[5], bl[6], bl[7]};
                    }
                }
        } else {
            const int t = (u.pn - 4) >> 1;
            bf16_t* dst = VV + (size_t)t * (size_t)(16u << 20);
            const int colb = ((u.pn - 4) & 1) * 256 + wc * 32 + 8 * fq;
#pragma unroll
            for (int ai = 0; ai < 2; ++ai)
#pragma unroll
                for (int m = 0; m < 4; ++m)
#pragma unroll
                    for (int bj = 0; bj < 2; ++bj) {
                        float v[8];
#pragma unroll
                        for (int n = 0; n < 2; ++n)
#pragma unroll
                            for (int e = 0; e < 4; ++e) { float x = acc[ai][bj][m][n][e];
                                if (t == 1) x = x * sigm(x);
                                else if (t == 3) { const float z = 1.5957691216f * (x + 0.044715f * x * x * x); x = x * sigm(z); }
                                v[4 * n + e] = x; }
                        const size_t off = (size_t)(row0 + ai * 128 + m * 16) * 512 + colb + bj * 128;
                        *(u32x4*)(dst + off) = (u32x4){cvt_pk_bf16(v[0], v[1]), cvt_pk_bf16(v[2], v[3]), cvt_pk_bf16(v[4], v[5]), cvt_pk_bf16(v[6], v[7])};
                    }
        }
    }
};

template <bool WRITE_B>
struct EpiRes {
    static constexpr bool PERM = true;
    const float* base; float* out; bf16_t* outb; float* part;
    __device__ __forceinline__ void operator()(const AccT& acc, const pg8::Unit& u, int wr, int wc, int fr, int fq) const {
        const int row0 = u.pm * 256 + wr * 64 + fr, colt = u.pn * 256 + wc * 32 + 8 * fq;
#pragma unroll
        for (int ai = 0; ai < 2; ++ai)
#pragma unroll
            for (int m = 0; m < 4; ++m) {
                const int row = row0 + ai * 128 + m * 16; float ss = 0.f;
#pragma unroll
                for (int bj = 0; bj < 2; ++bj) {
                    const size_t off = (size_t)row * DM + colt + bj * 128;
                    const f32x4 v0 = acc[ai][bj][m][0] + *(const f32x4*)(base + off), v1 = acc[ai][bj][m][1] + *(const f32x4*)(base + off + 4);
                    *(f32x4*)(out + off) = v0; *(f32x4*)(out + off + 4) = v1;
                    if (WRITE_B) *(u32x4*)(outb + off) = (u32x4){cvt_pk_bf16(v0[0], v0[1]), cvt_pk_bf16(v0[2], v0[3]), cvt_pk_bf16(v1[0], v1[1]), cvt_pk_bf16(v1[2], v1[3])};
                    ss += (v0[0] * v0[0] + v0[1] * v0[1]) + (v0[2] * v0[2] + v0[3] * v0[3]) + (v1[0] * v1[0] + v1[1] * v1[1]) + (v1[2] * v1[2] + v1[3] * v1[3]);
                }
                ss += __shfl_xor(ss, 16); ss += __shfl_xor(ss, 32);
                if (fq == 0) part[(size_t)row * 16 + u.pn * 4 + wc] = ss;
            }
    }
};

struct EpiG3 {
    static constexpr bool PERM = true;
    const float* part; bf16_t* ACT;
    __device__ __forceinline__ void operator()(const AccT& acc, const pg8::Unit& u, int wr, int wc, int fr, int fq) const {
        const int row0 = u.pm * 256 + wr * 64 + fr, col = u.pn * 128 + wc * 32 + 8 * fq;
#pragma unroll
        for (int ai = 0; ai < 2; ++ai)
#pragma unroll
            for (int m = 0; m < 4; ++m) {
                const int row = row0 + ai * 128 + m * 16;
                const f32x4* pp = (const f32x4*)(part + (size_t)row * 16);
                const f32x4 s4 = (pp[0] + pp[1]) + (pp[2] + pp[3]);
                const float rs = __builtin_amdgcn_rsqf(((s4[0] + s4[1]) + (s4[2] + s4[3])) * (1.f / DM) + EPS);
                float v[8];
#pragma unroll
                for (int n = 0; n < 2; ++n)
#pragma unroll
                    for (int e = 0; e < 4; ++e) { const float g = acc[ai][0][m][n][e] * rs, up = acc[ai][1][m][n][e] * rs; v[4 * n + e] = g * sigm(g) * up; }
                *(u32x4*)(ACT + (size_t)row * DFF + col) = (u32x4){cvt_pk_bf16(v[0], v[1]), cvt_pk_bf16(v[2], v[3]), cvt_pk_bf16(v[4], v[5]), cvt_pk_bf16(v[6], v[7])};
            }
    }
};

struct Args { const float* in[17]; float* out; unsigned char* ws; int ph_lo, ph_hi; };
enum { I_X = 0, I_MIXNW, I_WIN, I_HGLB, I_HGNW, I_CONVW, I_CONVB, I_WA, I_BA, I_WX, I_BX, I_LRUA, I_WOUT, I_FFNNW, I_WGU, I_WDN, I_FINW };

DI unsigned f2bf(float f) { unsigned u = __builtin_bit_cast(unsigned, f); return (u + 0x7fffu + ((u >> 16) & 1u)) >> 16; }
DI unsigned pk2(float lo, float hi) { return f2bf(lo) | (f2bf(hi) << 16); }
DI void p0_transpose_item(const float* W, int K, int N, bf16_t* WT, int kb, int n0, int dst_n0, const float* kscale, LAS float* scr, int lane) {
    const int k0 = 64 * kb;
#pragma unroll 8
    for (int i = 0; i < 32; ++i) { const int kk = 2 * i + (lane >> 5); float w = W[(size_t)(k0 + kk) * N + n0 + (lane & 31)]; if (kscale) w *= kscale[k0 + kk]; scr[kk * 33 + (lane & 31)] = w; }
    asm volatile("s_waitcnt lgkmcnt(0)" ::: "memory");
    const int c = lane & 7;
#pragma unroll
    for (int j = 0; j < 4; ++j) { const int n = (lane >> 3) + 8 * j; const LAS float* s = scr + (8 * c) * 33 + n;
        u32x4 o; o.x = pk2(s[0 * 33], s[1 * 33]); o.y = pk2(s[2 * 33], s[3 * 33]); o.z = pk2(s[4 * 33], s[5 * 33]); o.w = pk2(s[6 * 33], s[7 * 33]);
        *(u32x4*)(WT + (size_t)(dst_n0 + n) * K + k0 + 8 * c) = o; }
    asm volatile("s_waitcnt lgkmcnt(0)" ::: "memory");
}
DI void p0_prologue(const Args& a, LAS unsigned char* lds, int wave, int lane) {
    LAS float* scr = (LAS float*)(lds + wave * 16384);
    const int gw = blockIdx.x * 8 + wave, NGW = gridDim.x * 8;
    unsigned char* ws = a.ws;
    constexpr int I_IN = (DM / 64) * (DIN / 32), I_OUT = (DM / 64) * (DM / 32), I_GU = (DM / 64) * (NGU / 32), I_DN = (DFF / 64) * (DM / 32);
    for (int it = gw; it < I_IN + I_OUT + I_GU + I_DN; it += NGW) {
        int r = it;
        if (r < I_IN) { const int nblk = DIN / 32, kb = r / nblk, n0 = 32 * (r % nblk); int d;
            if (n0 < 512) d = 256 * (n0 >> 7) + (n0 & 127); else if (n0 < 1024) { const int x = n0 - 512; d = 256 * (x >> 7) + 128 + (x & 127); } else d = n0;
            p0_transpose_item(a.in[I_WIN], DM, DIN, (bf16_t*)(ws + WS_WIN), kb, n0, d, nullptr, scr, lane); continue; }
        r -= I_IN;
        if (r < I_OUT) { const int nblk = DM / 32, kb = r / nblk, n0 = 32 * (r % nblk);
            p0_transpose_item(a.in[I_WOUT], DM, DM, (bf16_t*)(ws + WS_WOUT), kb, n0, n0, nullptr, scr, lane); continue; }
        r -= I_OUT;
        if (r < I_GU) { const int nblk = NGU / 32, kb = r / nblk, n0 = 32 * (r % nblk); int d;
            if (n0 < DFF) d = 256 * (n0 >> 7) + (n0 & 127); else { const int x = n0 - DFF; d = 256 * (x >> 7) + 128 + (x & 127); }
            p0_transpose_item(a.in[I_WGU], DM, NGU, (bf16_t*)(ws + WS_WGU), kb, n0, d, a.in[I_FFNNW], scr, lane); continue; }
        r -= I_GU;
        { const int nblk = DM / 32, kb = r / nblk, n0 = 32 * (r % nblk);
            p0_transpose_item(a.in[I_WDN], DFF, DM, (bf16_t*)(ws + WS_WDN), kb, n0, n0, nullptr, scr, lane); }
    }
    const float* x = a.in[I_X]; const float* nw = a.in[I_MIXNW]; bf16_t* XN = (bf16_t*)(ws + WS_XN);
    f32x4 w4[4];
#pragma unroll
    for (int j = 0; j < 4; ++j) w4[j] = ((const f32x4*)nw)[lane + 64 * j];
    for (int m = gw; m < M; m += NGW) {
        const f32x4* xr = (const f32x4*)(x + (size_t)m * DM) + lane;
        f32x4 v[4]; float s = 0.f;
#pragma unroll
        for (int j = 0; j < 4; ++j) { v[j] = xr[64 * j]; s += (v[j][0] * v[j][0] + v[j][1] * v[j][1]) + (v[j][2] * v[j][2] + v[j][3] * v[j][3]); }
        const float rstd = __builtin_amdgcn_rsqf(wave_sum(s) * (1.f / DM) + EPS);
        u32x2* o8 = (u32x2*)(XN + (size_t)m * DM) + lane;
#pragma unroll
        for (int j = 0; j < 4; ++j) { const f32x4 y = v[j] * rstd * w4[j]; o8[64 * j] = (u32x2){cvt_pk_bf16(y[0], y[1]), cvt_pk_bf16(y[2], y[3])}; }
    }
}

#define MFMA16(a, b, c) __builtin_amdgcn_mfma_f32_16x16x32_bf16((a), (b), (c), 0, 0, 0)
template <bool PC>
DI void hgrn_unit(LAS unsigned char* lds, const Args& a, int bh, int sc, int tid, int wid, int lane) {
    unsigned char* ws = a.ws;
    const bf16_t* QD = (const bf16_t*)(ws + WS_QD); const bf16_t* KD = (const bf16_t*)(ws + WS_KD); const bf16_t* KS = (const bf16_t*)(ws + WS_KS);
    const bf16_t* VV = (const bf16_t*)(ws + WS_VV); const bf16_t* GS = (const bf16_t*)(ws + WS_GS); bf16_t* MIXED = (bf16_t*)(ws + WS_MIXED);
    const float* BL = (const float*)(ws + WS_BL); float* SA = (float*)(ws + WS_SA); float* BLS = (float*)(ws + WS_BLS);
    const int b = bh >> 2, h = bh & 3, colb = h * 128, r = lane & 15, q = lane >> 4;
    LAS bf16_t* Qd = (LAS bf16_t*)lds; LAS bf16_t* Kd = (LAS bf16_t*)(lds + 8704); LAS bf16_t* Kst = (LAS bf16_t*)(lds + 17408); LAS bf16_t* Vt = (LAS bf16_t*)(lds + 27648);
    LAS bf16_t* St = (LAS bf16_t*)(lds + 37888); LAS float* RS = (LAS float*)(lds + 72704);
    const size_t row_base = (size_t)b * SEQ + (size_t)sc * 512;
    f32x4 S[8];
#pragma unroll
    for (int kb = 0; kb < 8; ++kb) S[kb] = (f32x4){0.f, 0.f, 0.f, 0.f};
    if (PC) {
        for (int sp = 0; sp < sc; ++sp) {
            const float* sa = SA + ((size_t)(bh * 8 + sp) * 8 + wid) * 2048; const float* bs = BLS + (size_t)(bh * 8 + sp) * 128;
#pragma unroll
            for (int kb = 0; kb < 8; ++kb) { const f32x4 d = *(const f32x4*)(bs + 16 * kb + 4 * q); const f32x4 v = *(const f32x4*)(sa + (kb * 64 + lane) * 4);
                S[kb] = (f32x4){S[kb][0] * fexp(d[0]) + v[0], S[kb][1] * fexp(d[1]) + v[1], S[kb][2] * fexp(d[2]) + v[2], S[kb][3] * fexp(d[3]) + v[3]}; }
        }
#pragma unroll
        for (int kb = 0; kb < 8; ++kb) *(LAS u32x2*)(St + (16 * wid + r) * 136 + 16 * kb + 4 * q) = (u32x2){cvt_pk_bf16(S[kb][0], S[kb][1]), cvt_pk_bf16(S[kb][2], S[kb][3])};
    }
    float blsum = 0.f;
    const int lr = tid & 31, lc = tid >> 5;
    u32x4 gq, gk, gs, gv;
    { const size_t off = (row_base + lr) * 512 + colb + lc * 8;
      if (PC) { gq = *(const u32x4*)(QD + off); gk = *(const u32x4*)(KD + off); }
      gs = *(const u32x4*)(KS + off); gv = *(const u32x4*)(VV + off); }
    f32x4 nwv = (f32x4){0.f, 0.f, 0.f, 0.f};
    if (PC) nwv = *(const f32x4*)(a.in[I_HGNW] + 16 * wid + 4 * q);
    for (int c = 0; c < 16; ++c) {
        __syncthreads();
        if (PC) { *(LAS u32x4*)(Qd + lr * 136 + lc * 8) = gq; *(LAS u32x4*)(Kd + lr * 136 + lc * 8) = gk; }
#pragma unroll
        for (int j = 0; j < 4; ++j) {
            Kst[(lc * 8 + 2 * j) * 40 + lr] = (bf16_t)(gs[j] & 0xffffu); Kst[(lc * 8 + 2 * j + 1) * 40 + lr] = (bf16_t)(gs[j] >> 16);
            Vt[(lc * 8 + 2 * j) * 40 + lr] = (bf16_t)(gv[j] & 0xffffu); Vt[(lc * 8 + 2 * j + 1) * 40 + lr] = (bf16_t)(gv[j] >> 16);
        }
        __syncthreads();
        if (c + 1 < 16) { const size_t off = (row_base + (c + 1) * 32 + lr) * 512 + colb + lc * 8;
            if (PC) { gq = *(const u32x4*)(QD + off); gk = *(const u32x4*)(KD + off); }
            gs = *(const u32x4*)(KS + off); gv = *(const u32x4*)(VV + off); }
        const size_t chunk_g = (row_base >> 5) + c;
        const float* blp = BL + chunk_g * 512 + colb;
        f32x4 dk[8];
#pragma unroll
        for (int kb = 0; kb < 8; ++kb) dk[kb] = *(const f32x4*)(blp + 16 * kb + 4 * q);
        if (!PC) { if (tid < 128) blsum += blp[tid]; }
        f32x4 o[2];
        if (PC) {
            bf16x8 qf[2][4];
#pragma unroll
            for (int tb = 0; tb < 2; ++tb)
#pragma unroll
                for (int ks = 0; ks < 4; ++ks) qf[tb][ks] = *(const LAS bf16x8*)(Qd + (16 * tb + r) * 136 + 32 * ks + 8 * q);
            f32x4 p00 = (f32x4){0.f, 0.f, 0.f, 0.f}, p01 = p00, p11 = p00;
#pragma unroll
            for (int ks = 0; ks < 4; ++ks) {
                const bf16x8 a0 = *(const LAS bf16x8*)(Kd + r * 136 + 32 * ks + 8 * q), a1 = *(const LAS bf16x8*)(Kd + (16 + r) * 136 + 32 * ks + 8 * q);
                p00 = MFMA16(a0, qf[0][ks], p00); p01 = MFMA16(a0, qf[1][ks], p01); p11 = MFMA16(a1, qf[1][ks], p11);
            }
#pragma unroll
            for (int i = 0; i < 4; ++i) if (r < 4 * q + i) { p00[i] = 0.f; p11[i] = 0.f; }
            u32x4 b0w = (u32x4){cvt_pk_bf16(p00[0], p00[1]), cvt_pk_bf16(p00[2], p00[3]), 0u, 0u};
            u32x4 b1w = (u32x4){cvt_pk_bf16(p01[0], p01[1]), cvt_pk_bf16(p01[2], p01[3]), cvt_pk_bf16(p11[0], p11[1]), cvt_pk_bf16(p11[2], p11[3])};
            const bf16x8 pb0 = __builtin_bit_cast(bf16x8, b0w), pb1 = __builtin_bit_cast(bf16x8, b1w);
            const u32x2 v0 = *(const LAS u32x2*)(Vt + (16 * wid + r) * 40 + 4 * q), v1 = *(const LAS u32x2*)(Vt + (16 * wid + r) * 40 + 16 + 4 * q);
            const bf16x8 av = __builtin_bit_cast(bf16x8, (u32x4){v0[0], v0[1], v1[0], v1[1]});
            o[0] = MFMA16(av, pb0, ((f32x4){0.f, 0.f, 0.f, 0.f})); o[1] = MFMA16(av, pb1, ((f32x4){0.f, 0.f, 0.f, 0.f}));
#pragma unroll
            for (int ks = 0; ks < 4; ++ks) { const bf16x8 sa = *(const LAS bf16x8*)(St + (16 * wid + r) * 136 + 32 * ks + 8 * q);
                o[0] = MFMA16(sa, qf[0][ks], o[0]); o[1] = MFMA16(sa, qf[1][ks], o[1]); }
#pragma unroll
            for (int tb = 0; tb < 2; ++tb) { float ss = (o[tb][0] * o[tb][0] + o[tb][1] * o[tb][1]) + (o[tb][2] * o[tb][2] + o[tb][3] * o[tb][3]);
                ss += __shfl_xor(ss, 16); ss += __shfl_xor(ss, 32); if (q == 0) RS[wid * 32 + 16 * tb + r] = ss; }
        }
        { const bf16x8 bv = *(const LAS bf16x8*)(Vt + (16 * wid + r) * 40 + 8 * q);
#pragma unroll
          for (int kb = 0; kb < 8; ++kb) { const bf16x8 ak = *(const LAS bf16x8*)(Kst + (16 * kb + r) * 40 + 8 * q);
              const f32x4 sd = (f32x4){S[kb][0] * fexp(dk[kb][0]), S[kb][1] * fexp(dk[kb][1]), S[kb][2] * fexp(dk[kb][2]), S[kb][3] * fexp(dk[kb][3])};
              S[kb] = MFMA16(ak, bv, sd); }
          if (PC) {
#pragma unroll
              for (int kb = 0; kb < 8; ++kb) *(LAS u32x2*)(St + (16 * wid + r) * 136 + 16 * kb + 4 * q) = (u32x2){cvt_pk_bf16(S[kb][0], S[kb][1]), cvt_pk_bf16(S[kb][2], S[kb][3])};
          } }
        if (PC) {
            __syncthreads();
#pragma unroll
            for (int tb = 0; tb < 2; ++tb) { const int t = 16 * tb + r; float tot = 0.f;
#pragma unroll
                for (int w = 0; w < 8; ++w) tot += RS[w * 32 + t];
                const float rstd = __builtin_amdgcn_rsqf(tot * (1.f / 128.f) + EPS);
                const size_t row = row_base + c * 32 + t;
                const u32x2 g2 = *(const u32x2*)(GS + row * 512 + colb + 16 * wid + 4 * q);
                const float y0 = o[tb][0] * rstd * nwv[0] * bflo(g2[0]), y1 = o[tb][1] * rstd * nwv[1] * bfhi(g2[0]), y2 = o[tb][2] * rstd * nwv[2] * bflo(g2[1]), y3 = o[tb][3] * rstd * nwv[3] * bfhi(g2[1]);
                *(u32x2*)(MIXED + row * DM + colb + 16 * wid + 4 * q) = (u32x2){cvt_pk_bf16(y0, y1), cvt_pk_bf16(y2, y3)}; }
        }
    }
    if (!PC) {
        float* sa = SA + ((size_t)(bh * 8 + sc) * 8 + wid) * 2048;
#pragma unroll
        for (int kb = 0; kb < 8; ++kb) *(f32x4*)(sa + (kb * 64 + lane) * 4) = S[kb];
        if (tid < 128) BLS[(size_t)(bh * 8 + sc) * 128 + tid] = blsum;
    }
    __syncthreads();
}

template <bool PC>
DI void lru_unit(LAS unsigned char* lds, const Args& a, int b, int n, int seg, int tid, int wid, int lane) {
    unsigned char* ws = a.ws;
    const bf16_t* LX = (const bf16_t*)(ws + WS_LX); const bf16_t* LG = (const bf16_t*)(ws + WS_LG); bf16_t* MIXED = (bf16_t*)(ws + WS_MIXED); float* LRT = (float*)(ws + WS_LRT);
    LAS bf16_t* Xs = (LAS bf16_t*)lds; LAS bf16_t* XCb = (LAS bf16_t*)(lds + 19456); LAS float* XCf = (LAS float*)(lds + 37888);
    const int r = lane & 15, q = lane >> 4, eb = wid & 3, th = wid >> 2, ch = n * 64 + eb * 16 + r;
    bf16x8 wa_f[2], wx_f[2];
    { const float* wa = a.in[I_WA] + (size_t)n * 4096; const float* wx = a.in[I_WX] + (size_t)n * 4096;
#pragma unroll
      for (int ks = 0; ks < 2; ++ks) { unsigned pa[4], px[4];
#pragma unroll
          for (int j2 = 0; j2 < 4; ++j2) { const int d = 32 * ks + 8 * q + 2 * j2;
              pa[j2] = pk2(wa[d * 64 + eb * 16 + r], wa[(d + 1) * 64 + eb * 16 + r]); px[j2] = pk2(wx[d * 64 + eb * 16 + r], wx[(d + 1) * 64 + eb * 16 + r]); }
          wa_f[ks] = __builtin_bit_cast(bf16x8, (u32x4){pa[0], pa[1], pa[2], pa[3]}); wx_f[ks] = __builtin_bit_cast(bf16x8, (u32x4){px[0], px[1], px[2], px[3]}); } }
    const float ba = a.in[I_BA][ch], bx = a.in[I_BX][ch];
    const float ap = a.in[I_LRUA][ch];
    const float sp8 = 8.f * (ap > 15.f ? fexp(-ap) : __logf(1.f + fexp(-ap)));
    const int seg2 = seg * 2 + th;
    float carry = 0.f, Atot = 1.f, Btot = 0.f;
    if (PC) { for (int s = 0; s < seg2; ++s) { const f32x2 ab = *(const f32x2*)(LRT + ((size_t)(b * 16 + s) * 512 + ch) * 2); carry = ab[0] * carry + ab[1]; } }
    const int cc = tid & 7;
    const float* cw = a.in[I_CONVW] + n * 64 + cc * 8; const float* cb = a.in[I_CONVB] + n * 64 + cc * 8;
    for (int j = 0; j < 4; ++j) {
        __syncthreads();
        for (int it = tid; it < 1072; it += 512) {
            const int th2 = it >= 536, rem = it - th2 * 536, row = rem >> 3, c8 = rem & 7;
            const int tok = seg * 512 + th2 * 256 + j * 64 + row - 3;
            u32x4 v = (u32x4){0u, 0u, 0u, 0u};
            if (tok >= 0) v = *(const u32x4*)(LX + ((size_t)b * SEQ + tok) * 512 + n * 64 + c8 * 8);
            *(LAS u32x4*)(Xs + (th2 * 67 + row) * 72 + c8 * 8) = v;
        }
        __syncthreads();
#pragma unroll
        for (int k = 0; k < 2; ++k) {
            const int it = tid + 512 * k, th2 = it >> 9, t = (it >> 3) & 63;
            float xc[8];
#pragma unroll
            for (int c = 0; c < 8; ++c) xc[c] = cb[c];
#pragma unroll
            for (int tap = 0; tap < 4; ++tap) { const u32x4 xv = *(const LAS u32x4*)(Xs + (th2 * 67 + t + tap) * 72 + cc * 8);
                const f32x4 w0 = *(const f32x4*)(cw + tap * 512), w1 = *(const f32x4*)(cw + tap * 512 + 4);
                xc[0] += bflo(xv[0]) * w0[0]; xc[1] += bfhi(xv[0]) * w0[1]; xc[2] += bflo(xv[1]) * w0[2]; xc[3] += bfhi(xv[1]) * w0[3];
                xc[4] += bflo(xv[2]) * w1[0]; xc[5] += bfhi(xv[2]) * w1[1]; xc[6] += bflo(xv[3]) * w1[2]; xc[7] += bfhi(xv[3]) * w1[3]; }
            *(LAS u32x4*)(XCb + (th2 * 64 + t) * 72 + cc * 8) = (u32x4){cvt_pk_bf16(xc[0], xc[1]), cvt_pk_bf16(xc[2], xc[3]), cvt_pk_bf16(xc[4], xc[5]), cvt_pk_bf16(xc[6], xc[7])};
            *(LAS f32x4*)(XCf + (th2 * 64 + t) * 68 + cc * 8) = (f32x4){xc[0], xc[1], xc[2], xc[3]};
            *(LAS f32x4*)(XCf + (th2 * 64 + t) * 68 + cc * 8 + 4) = (f32x4){xc[4], xc[5], xc[6], xc[7]};
        }
        __syncthreads();
        for (int tb = 0; tb < 4; ++tb) {
            f32x4 R = (f32x4){0.f, 0.f, 0.f, 0.f}, I = R;
#pragma unroll
            for (int ks = 0; ks < 2; ++ks) { const bf16x8 af = *(const LAS bf16x8*)(XCb + (th * 64 + 16 * tb + r) * 72 + 32 * ks + 8 * q);
                R = MFMA16(af, wa_f[ks], R); I = MFMA16(af, wx_f[ks], I); }
            float av[4], bv[4];
            const size_t tok0 = (size_t)b * SEQ + seg * 512 + th * 256 + j * 64 + 16 * tb + 4 * q;
#pragma unroll
            for (int i = 0; i < 4; ++i) {
                const float xcv = XCf[(th * 64 + 16 * tb + 4 * q + i) * 68 + eb * 16 + r];
                const float rg = sigm(R[i] + ba), ig = sigm(I[i] + bx);
                const float aa = fexp(-sp8 * rg);
                av[i] = aa; bv[i] = __builtin_sqrtf(fmaxf(1.f - aa * aa, 0.f)) * ig * xcv;
            }
            float Al = av[0], Bl = bv[0];
#pragma unroll
            for (int i = 1; i < 4; ++i) { Bl = av[i] * Bl + bv[i]; Al *= av[i]; }
            float Ai = Al, Bi = Bl;
            { const float Ap = __shfl_up(Ai, 16), Bp = __shfl_up(Bi, 16); if (q >= 1) { Bi = Ai * Bp + Bi; Ai = Ai * Ap; } }
            { const float Ap = __shfl_up(Ai, 32), Bp = __shfl_up(Bi, 32); if (q >= 2) { Bi = Ai * Bp + Bi; Ai = Ai * Ap; } }
            float Ae = __shfl_up(Ai, 16), Be = __shfl_up(Bi, 16); if (q == 0) { Ae = 1.f; Be = 0.f; }
            const float A3 = __shfl(Ai, r + 48), B3 = __shfl(Bi, r + 48);
            if (PC) {
                float hcur = Ae * carry + Be;
#pragma unroll
                for (int i = 0; i < 4; ++i) { hcur = av[i] * hcur + bv[i];
                    const float gg = bf2f(LG[(tok0 + i) * 512 + ch]);
                    MIXED[(tok0 + i) * DM + 512 + ch] = (bf16_t)f2bf(hcur * gg); }
                carry = A3 * carry + B3;
            } else { Btot = A3 * Btot + B3; Atot *= A3; }
        }
    }
    if (!PC) { if (q == 0) *(f32x2*)(LRT + ((size_t)(b * 16 + seg2) * 512 + ch) * 2) = (f32x2){Atot, Btot}; }
    __syncthreads();
}

__global__ void __launch_bounds__(512, 2) fwd_megakernel(Args a) {
    extern __shared__ __attribute__((aligned(16))) unsigned char lds_raw[];
    LAS unsigned char* lds = (LAS unsigned char*)lds_raw;
    cg::grid_group grid = cg::this_grid();
    const int tid = threadIdx.x, lane = tid & 63, wid = __builtin_amdgcn_readfirstlane(tid >> 6);
    const int lo = a.ph_lo, hi = a.ph_hi, G = gridDim.x;
    unsigned char* ws = a.ws;
#define IN(k) (lo <= (k) && (k) < hi)
#define SEAM(k) do { if (IN(k) && IN((k) + 1)) { asm volatile("s_waitcnt vmcnt(0) lgkmcnt(0)" ::: "memory"); grid.sync(); __builtin_amdgcn_fence(__ATOMIC_ACQUIRE, "agent"); asm volatile("s_waitcnt vmcnt(0)" ::: "memory"); } } while (0)
    if (IN(0)) { p0_prologue(a, lds, wid, lane); }
    SEAM(0);
    if (IN(1)) {
        pg8::Gemm g{(const bf16_t*)(ws + WS_XN), (const bf16_t*)(ws + WS_WIN), M, DIN, DM}; pg8::StaticOrder S; S.init(M, DIN, G, (int)blockIdx.x);
        EpiG1 E{(bf16_t*)(ws + WS_QD), (bf16_t*)(ws + WS_KD), (bf16_t*)(ws + WS_KS), (bf16_t*)(ws + WS_VV), (bf16_t*)(ws + WS_GS), (bf16_t*)(ws + WS_LX), (bf16_t*)(ws + WS_LG), (float*)(ws + WS_BL), a.in[I_HGLB]};
        pg8::gemm_phase<EpiG1, true>(lds, g, S, E);
    }
    SEAM(1);
    if (IN(2)) {
        for (int u = blockIdx.x; u < 224; u += G) hgrn_unit<false>(lds, a, u / 7, u % 7, tid, wid, lane);
        for (int u = blockIdx.x; u < 512; u += G) lru_unit<false>(lds, a, u >> 6, (u >> 3) & 7, u & 7, tid, wid, lane);
    }
    SEAM(2);
    if (IN(3)) {
        for (int u = blockIdx.x; u < 256; u += G) hgrn_unit<true>(lds, a, u >> 3, u & 7, tid, wid, lane);
        for (int u = blockIdx.x; u < 512; u += G) lru_unit<true>(lds, a, u >> 6, (u >> 3) & 7, u & 7, tid, wid, lane);
    }
    SEAM(3);
    if (IN(4)) {
        pg8::Gemm g{(const bf16_t*)(ws + WS_MIXED), (const bf16_t*)(ws + WS_WOUT), M, DM, DM}; pg8::StaticOrder S; S.init(M, DM, G, (int)blockIdx.x);
        EpiRes<true> E{a.in[I_X], (float*)(ws + WS_H1), (bf16_t*)(ws + WS_H1B), (float*)(ws + WS_PART1)};
        pg8::gemm_phase<EpiRes<true>, true>(lds, g, S, E);
    }
    SEAM(4);
    if (IN(5)) {
        pg8::Gemm g{(const bf16_t*)(ws + WS_H1B), (const bf16_t*)(ws + WS_WGU), M, NGU, DM}; pg8::StaticOrder S; S.init(M, NGU, G, (int)blockIdx.x);
        EpiG3 E{(const float*)(ws + WS_PART1), (bf16_t*)(ws + WS_ACT)};
        pg8::gemm_phase<EpiG3, true>(lds, g, S, E);
    }
    SEAM(5);
    if (IN(6)) {
        pg8::Gemm g{(const bf16_t*)(ws + WS_ACT), (const bf16_t*)(ws + WS_WDN), M, DM, DFF}; pg8::StaticOrder S; S.init(M, DM, G, (int)blockIdx.x);
        EpiRes<false> E{(const float*)(ws + WS_H1), a.out, nullptr, (float*)(ws + WS_PART2)};
        pg8::gemm_phase<EpiRes<false>, true>(lds, g, S, E);
    }
    SEAM(6);
    if (IN(7)) {
        const float* part = (const float*)(ws + WS_PART2); const float* fw = a.in[I_FINW];
        f32x4 w4[4];
#pragma unroll
        for (int j = 0; j < 4; ++j) w4[j] = ((const f32x4*)fw)[lane + 64 * j];
        for (int m = blockIdx.x * 8 + wid; m < M; m += G * 8) {
            const float p = lane < 16 ? part[(size_t)m * 16 + lane] : 0.f;
            const float rstd = __builtin_amdgcn_rsqf(wave_sum(p) * (1.f / DM) + EPS);
            f32x4* xr = (f32x4*)(a.out + (size_t)m * DM) + lane;
#pragma unroll
            for (int j = 0; j < 4; ++j) xr[64 * j] = xr[64 * j] * rstd * w4[j];
        }
    }
#undef IN
#undef SEAM
}

extern "C" void kernel_launch(void* const* d_in, const int* in_sizes, int n_in, void* d_out, int out_size, void* d_ws, size_t ws_size, hipStream_t stream) {
    static int grid = 0;
    if (grid == 0) {
        if (n_in != 17 || out_size != M * DM || ws_size < WS_END) { fprintf(stderr, "kernel_launch: unexpected shapes (n_in %d, out %d, ws %zu)\n", n_in, out_size, ws_size); grid = -1; return; }
        int dev = 0, cus = 0, per_cu = 0;
        (void)hipGetDevice(&dev); (void)hipDeviceGetAttribute(&cus, hipDeviceAttributeMultiprocessorCount, dev);
        if (hipFuncSetAttribute((const void*)fwd_megakernel, hipFuncAttributeMaxDynamicSharedMemorySize, LDS_BYTES) != hipSuccess) { fprintf(stderr, "kernel_launch: hipFuncSetAttribute failed\n"); grid = -1; return; }
        if (hipOccupancyMaxActiveBlocksPerMultiprocessor(&per_cu, (const void*)fwd_megakernel, 512, LDS_BYTES) != hipSuccess || per_cu < 1) { fprintf(stderr, "kernel_launch: occupancy query says %d blocks/CU\n", per_cu); per_cu = 1; }
        (void)hipGetLastError();
        grid = cus * (per_cu < 1 ? 1 : 1);
        fprintf(stderr, "kernel_launch: grid %d (cus %d, per_cu %d)\n", grid, cus, per_cu);
    }
    if (grid < 0) return;
    Args a{};
    for (int i = 0; i < 17; ++i) a.in[i] = (const float*)d_in[i];
    a.out = (float*)d_out; a.ws = (unsigned char*)d_ws;
#if MK_N_LAUNCHES == 1
    a.ph_lo = 0; a.ph_hi = NPH;
    void* args[] = {&a};
    hipError_t e = hipLaunchCooperativeKernel((const void*)fwd_megakernel, dim3(grid), dim3(512), args, LDS_BYTES, stream);
    if (e != hipSuccess) fprintf(stderr, "cooperative launch failed: %s (grid %d)\n", hipGetErrorString(e), grid);
#else
    for (int p = 0; p < NPH; ++p) { a.ph_lo = p; a.ph_hi = p + 1; hipLaunchKernelGGL(fwd_megakernel, dim3(grid), dim3(512), LDS_BYTES, stream, a); }
#endif
}
```

```cpp
#include <hip/hip_runtime.h>
#include <hip/hip_cooperative_groups.h>
#include <cstdio>
#include <cstdint>
namespace cg = cooperative_groups;

#define LAS __attribute__((address_space(3)))
#define DI __device__ __forceinline__
typedef unsigned short bf16_t;
typedef short bf16x8 __attribute__((ext_vector_type(8)));
typedef float f32x4 __attribute__((ext_vector_type(4)));
typedef float f32x2 __attribute__((ext_vector_type(2)));
typedef unsigned u32x4 __attribute__((ext_vector_type(4)));
typedef unsigned u32x2 __attribute__((ext_vector_type(2)));

#ifndef MK_N_LAUNCHES
#define MK_N_LAUNCHES 1
#endif

constexpr int BATCH = 8, SEQ = 4096, DM = 1024, M = BATCH * SEQ;
constexpr int DIN = 3072, DFF = 2816, NGU = 2 * DFF;
constexpr float EPS = 1e-6f;
constexpr int NPH = 8;

constexpr size_t MiB = 1u << 20;
constexpr size_t WS_CTL = 0, CTL_ZERO_BYTES = 16384;
constexpr size_t WS_PART1 = 1 * MiB;
constexpr size_t WS_PART2 = 3 * MiB;
constexpr size_t WS_BL = 5 * MiB;
constexpr size_t WS_LRT = 7 * MiB;
constexpr size_t WS_BLS = 7 * MiB + 512 * 1024;
constexpr size_t WS_WIN = 8 * MiB, WS_WOUT = 14 * MiB, WS_WGU = 16 * MiB, WS_WDN = 27 * MiB;
constexpr size_t WS_SA = 34 * MiB;
constexpr size_t WS_XN = 50 * MiB;
constexpr size_t WS_MIXED = 114 * MiB;
constexpr size_t WS_ACT = 50 * MiB;
constexpr size_t WS_QD = 226 * MiB, WS_KD = 258 * MiB, WS_KS = 290 * MiB, WS_VV = 322 * MiB, WS_GS = 354 * MiB, WS_LX = 386 * MiB, WS_LG = 418 * MiB;
constexpr size_t WS_H1 = 226 * MiB;
constexpr size_t WS_H1B = 354 * MiB;
constexpr size_t WS_END = 450 * MiB;

constexpr int LDS_BYTES = 147456, LDS_MISC_OFF = 147456 - 64;

typedef __bf16 bf16x2v __attribute__((ext_vector_type(2)));
DI unsigned cvt_pk_bf16(float lo, float hi) { f32x2 v = {lo, hi}; bf16x2v b = __builtin_convertvector(v, bf16x2v); return __builtin_bit_cast(unsigned, b); }
DI float bf2f(unsigned short h) { return __builtin_bit_cast(float, (unsigned)h << 16); }
DI float bflo(unsigned w) { return __builtin_bit_cast(float, w << 16); }
DI float bfhi(unsigned w) { return __builtin_bit_cast(float, w & 0xffff0000u); }
DI float fexp(float x) { return __expf(x); }
DI float frcp(float x) { return __builtin_amdgcn_rcpf(x); }
DI float sigm(float x) { return frcp(1.f + fexp(-x)); }
DI float wave_sum(float v) {
#pragma unroll
    for (int o = 1; o < 64; o <<= 1) v += __shfl_xor(v, o);
    return v;
}
template <int D_> DI float dpp_shr(float v) { return __builtin_bit_cast(float, __builtin_amdgcn_update_dpp(0, __builtin_bit_cast(int, v), 0x110 + D_, 0xf, 0xf, true)); }
DI float scan16(float v) { v += dpp_shr<1>(v); v += dpp_shr<2>(v); v += dpp_shr<4>(v); v += dpp_shr<8>(v); return v; }
DI float row_last(float v) { return __shfl(v, 15, 16); }

namespace pg8 {
constexpr int BM = 256, BK = 64, HALF = 128, HTB = HALF * BK * 2, STAGE_BYTES = 8 * HTB, NXCD = 8, WGM = 8;
__host__ __device__ __forceinline__ int lds_byte(int r, int c) { const int st = (r >> 4) * 2 + (c >> 5), rr = r & 15, cc = c & 31, ob = rr * 64 + cc * 2; return st * 1024 + (ob ^ (((ob >> 9) & 1) << 5)); }
__host__ __device__ __forceinline__ void stage_rc(int b, int& R, int& C) { const int st = b / 1024, sb = b % 1024, swz = sb ^ (((sb >> 9) & 1) << 5); R = (st >> 1) * 16 + swz / 64; C = (st & 1) * 32 + (swz % 64) / 2; }
__host__ __device__ __forceinline__ int perm32(int rho) { const int n = rho >> 4, i = rho & 15; return 8 * (i >> 2) + 4 * n + (i & 3); }
struct Unit { int pm, pn; };
struct Gemm { const bf16_t* A; const bf16_t* Bt; int M, N, K; };
struct StaticOrder {
    int nM, nN, nwg, G, c;
    __host__ __device__ void init(int M_, int N_, int G_, int c_) { nM = M_ / BM; nN = N_ / BM; nwg = nM * nN; G = G_; c = c_; }
    __host__ __device__ bool next(int i, Unit& u) const {
        const long L = (long)i * G + c; if (L >= nwg) return false;
        int wgid = (int)L; { const int q = nwg / NXCD, r = nwg % NXCD, xcd = wgid % NXCD, off = wgid / NXCD; wgid = (xcd < r ? xcd * (q + 1) : r * (q + 1) + (xcd - r) * q) + off; }
        const int nig = WGM * nN, gid = wgid / nig, fm = gid * WGM, gsz = (nM - fm) < WGM ? (nM - fm) : WGM;
        u.pm = fm + ((wgid % nig) % gsz); u.pn = (wgid % nig) / gsz; return true;
    }
};

template <class Epi, bool ALIGN_EPI>
__device__ __forceinline__ void gemm_phase(LAS unsigned char* lds, const Gemm g, const StaticOrder& S, const Epi& E) {
    const int tid = threadIdx.x, wid = __builtin_amdgcn_readfirstlane(tid >> 6), lane = tid & 63, wr = wid >> 2, wc = wid & 3, fr = lane & 15, fq = lane >> 4;
    const int K = g.K, nt = K / BK;
    unsigned voffA[2], voffB[2];
#pragma unroll
    for (int i = 0; i < 2; ++i) { int R, C; stage_rc(tid * 16 + i * 8192, R, C); const int Rb = Epi::PERM ? ((R & ~31) + perm32(R & 31)) : R;
        voffA[i] = (unsigned)(R * K + C) * 2u; voffB[i] = (unsigned)(Rb * K + C) * 2u; }
    const size_t kstep = (size_t)(BK * 2);
    const size_t hstep = (size_t)HALF * K * 2;
    const size_t tstep = 2 * hstep;
    const unsigned ldsw = (unsigned)wid * 1024u;
    const int aoff = lds_byte(wr * 64 + fr, fq * 8), boff = lds_byte(wc * 32 + fr, fq * 8);
#define PG8_SA(b, h) (((b) * 2 + (h)) * HTB)
#define PG8_SB(b, h) ((4 + (b) * 2 + (h)) * HTB)
#define PG8_STAGE(bufoff, gbase, voff) do { _Pragma("unroll") for (int _i = 0; _i < 2; ++_i) \
        __builtin_amdgcn_global_load_lds((const unsigned*)((const char*)(gbase) + (voff)[_i]), (LAS unsigned*)(lds + (bufoff) + ldsw + _i * 8192), 16, 0, 0); } while (0)
#define PG8_LDA(dst, b, h) do { _Pragma("unroll") for (int m = 0; m < 4; ++m) _Pragma("unroll") for (int k = 0; k < 2; ++k) dst[m][k] = *(const LAS bf16x8*)(lds + PG8_SA(b, h) + aoff + m * 2048 + k * 1024); } while (0)
#define PG8_LDB(dst, b, h) do { _Pragma("unroll") for (int n = 0; n < 2; ++n) _Pragma("unroll") for (int k = 0; k < 2; ++k) dst[n][k] = *(const LAS bf16x8*)(lds + PG8_SB(b, h) + boff + n * 2048 + k * 1024); } while (0)
#define PG8_MMA(ai, bj, At, Bt) do { __builtin_amdgcn_s_setprio(1); _Pragma("unroll") for (int m = 0; m < 4; ++m) _Pragma("unroll") for (int n = 0; n < 2; ++n) _Pragma("unroll") for (int k = 0; k < 2; ++k) \
        acc[ai][bj][m][n] = __builtin_amdgcn_mfma_f32_16x16x32_bf16(Bt[n][k], At[m][k], acc[ai][bj][m][n], 0, 0, 0); __builtin_amdgcn_s_setprio(0); } while (0)
#define PG8_WAIT_V(n) asm volatile("s_waitcnt vmcnt(" #n ")" ::: "memory")
#define PG8_WAIT_L(n) asm volatile("s_waitcnt lgkmcnt(" #n ")" ::: "memory")
#define PG8_BAR __builtin_amdgcn_s_barrier()
#define PG8_SCHED __builtin_amdgcn_sched_barrier(0)
    Unit cur, nxt; int ui = 0;
    if (!S.next(0, cur)) return;
    f32x4 acc[2][2][4][2];
#pragma unroll
    for (int a = 0; a < 2; ++a)
#pragma unroll
        for (int b = 0; b < 2; ++b)
#pragma unroll
            for (int m = 0; m < 4; ++m)
#pragma unroll
                for (int n = 0; n < 2; ++n) acc[a][b][m][n] = (f32x4){0.f, 0.f, 0.f, 0.f};
    bf16x8 At[4][2], B0[2][2], B1[2][2];
    const char* cA = (const char*)g.A + (size_t)cur.pm * tstep; const char* cB = (const char*)g.Bt + (size_t)cur.pn * tstep;
    PG8_STAGE(PG8_SB(0, 0), cB, voffB); PG8_STAGE(PG8_SB(0, 1), cB + hstep, voffB); PG8_STAGE(PG8_SA(0, 0), cA, voffA); PG8_STAGE(PG8_SA(0, 1), cA + hstep, voffA);
    if (wr == 1) PG8_BAR;
    PG8_WAIT_V(2); PG8_BAR;
    PG8_STAGE(PG8_SB(1, 0), cB + kstep, voffB); PG8_STAGE(PG8_SA(1, 0), cA + kstep, voffA); PG8_STAGE(PG8_SB(1, 1), cB + hstep + kstep, voffB);
    PG8_WAIT_V(6); PG8_BAR;
    for (;;) {
        const bool has_next = S.next(ui + 1, nxt);
        const char* nA = has_next ? (const char*)g.A + (size_t)nxt.pm * tstep : cA; const char* nB = has_next ? (const char*)g.Bt + (size_t)nxt.pn * tstep : cB;
        for (int t = 0; t < nt; t += 2) {
            const bool last = (t == nt - 2);
            const char* a1 = cA + (size_t)(t + 1) * kstep;
            const char* a2 = last ? nA : cA + (size_t)(t + 2) * kstep; const char* b2 = last ? nB : cB + (size_t)(t + 2) * kstep;
            const char* a3 = a2 + kstep; const char* b3 = b2 + kstep;
            PG8_LDB(B0, 0, 0); PG8_LDB(B1, 0, 1); PG8_SCHED; PG8_LDA(At, 0, 0); PG8_STAGE(PG8_SA(1, 1), a1 + hstep, voffA);
            PG8_WAIT_V(8); PG8_WAIT_L(0); PG8_BAR; PG8_MMA(0, 0, At, B0); PG8_MMA(0, 1, At, B1); PG8_BAR; PG8_SCHED;
            PG8_LDA(At, 0, 1); PG8_STAGE(PG8_SB(0, 0), b2, voffB); PG8_STAGE(PG8_SB(0, 1), b2 + hstep, voffB); PG8_STAGE(PG8_SA(0, 0), a2, voffA);
            PG8_WAIT_V(8); PG8_WAIT_L(0); PG8_BAR; PG8_MMA(1, 0, At, B0); PG8_MMA(1, 1, At, B1); PG8_BAR; PG8_SCHED;
            PG8_LDB(B0, 1, 0); PG8_LDB(B1, 1, 1); PG8_SCHED; PG8_LDA(At, 1, 0); PG8_STAGE(PG8_SA(0, 1), a2 + hstep, voffA);
            PG8_WAIT_V(8); PG8_WAIT_L(0); PG8_BAR; PG8_MMA(0, 0, At, B0); PG8_MMA(0, 1, At, B1); PG8_BAR; PG8_SCHED;
            PG8_LDA(At, 1, 1); PG8_STAGE(PG8_SB(1, 0), b3, voffB); PG8_STAGE(PG8_SB(1, 1), b3 + hstep, voffB); PG8_STAGE(PG8_SA(1, 0), a3, voffA);
            PG8_WAIT_V(8); PG8_WAIT_L(0); PG8_BAR; PG8_MMA(1, 0, At, B0); PG8_MMA(1, 1, At, B1); PG8_BAR; PG8_SCHED;
        }
        if constexpr (ALIGN_EPI) { if (wr == 0) PG8_BAR; }
        E(acc, cur, wr, wc, fr, fq);
        if (!has_next) break;
#pragma unroll
        for (int a = 0; a < 2; ++a)
#pragma unroll
            for (int b = 0; b < 2; ++b)
#pragma unroll
                for (int m = 0; m < 4; ++m)
#pragma unroll
                    for (int n = 0; n < 2; ++n) acc[a][b][m][n] = (f32x4){0.f, 0.f, 0.f, 0.f};
        cur = nxt; cA = nA; cB = nB; ++ui;
        if constexpr (ALIGN_EPI) { if (wr == 1) PG8_BAR; }
    }
    PG8_WAIT_V(0);
    if constexpr (!ALIGN_EPI) { if (wr == 0) PG8_BAR; }
    PG8_BAR;
#undef PG8_SA
#undef PG8_SB
#undef PG8_STAGE
#undef PG8_LDA
#undef PG8_LDB
#undef PG8_MMA
#undef PG8_WAIT_V
#undef PG8_WAIT_L
#undef PG8_BAR
#undef PG8_SCHED
}
}

typedef f32x4 AccT[2][2][4][2];

struct EpiG1 {
    static constexpr bool PERM = true;
    bf16_t *QD, *KD, *KS, *VV, *GS, *LX, *LG; float* BL; const float* hg_lb;
    __device__ __forceinline__ void operator()(const AccT& acc, const pg8::Unit& u, int wr, int wc, int fr, int fq) const {
        const int row0 = u.pm * 256 + wr * 64 + fr;
        if (u.pn < 4) {
            const int h = u.pn, kc = h * 128 + wc * 32 + 8 * fq;
            float lbv[8], olb[8];
#pragma unroll
            for (int j = 0; j < 8; ++j) { const float a0 = hg_lb[kc + j], a1 = hg_lb[512 + kc + j]; lbv[j] = frcp(1.f + fexp(a1 - a0)); olb[j] = 1.f - lbv[j]; }
#pragma unroll
            for (int ai = 0; ai < 2; ++ai)
#pragma unroll
                for (int cp = 0; cp < 2; ++cp) {
                    unsigned qd[2][4], kd[2][4], ks[2][4]; float bl[8];
#pragma unroll
                    for (int n = 0; n < 2; ++n)
#pragma unroll
                        for (int e2 = 0; e2 < 2; ++e2) {
                            float oq[2][2], ok[2][2], os[2][2];
#pragma unroll
                            for (int ee = 0; ee < 2; ++ee) {
                                const int e = e2 * 2 + ee, j = 4 * n + e;
                                const float x0 = acc[ai][1][2 * cp][n][e], x1 = acc[ai][1][2 * cp + 1][n][e];
                                const float e0 = fexp(-x0), e1 = fexp(-x1), i0 = frcp(1.f + e0), i1 = frcp(1.f + e1);
                                const float f0 = lbv[j] + olb[j] * i0, f1 = lbv[j] + olb[j] * i1;
                                const float k0 = 1.f - f0, k1 = 1.f - f1;
                                const float p0 = scan16(__logf(f0)); const float t0 = row_last(p0);
                                const float p1 = scan16(__logf(f1)) + t0; const float bt = row_last(p1);
                                bl[j] = bt;
                                const float q0 = acc[ai][0][2 * cp][n][e], q1 = acc[ai][0][2 * cp + 1][n][e];
                                oq[0][ee] = q0 * sigm(q0) * fexp(p0); oq[1][ee] = q1 * sigm(q1) * fexp(p1);
                                ok[0][ee] = k0 * fexp(-p0); ok[1][ee] = k1 * fexp(-p1);
                                os[0][ee] = k0 * fexp(bt - p0); os[1][ee] = k1 * fexp(bt - p1);
                            }
#pragma unroll
                            for (int mm = 0; mm < 2; ++mm) { qd[mm][2 * n + e2] = cvt_pk_bf16(oq[mm][0], oq[mm][1]); kd[mm][2 * n + e2] = cvt_pk_bf16(ok[mm][0], ok[mm][1]); ks[mm][2 * n + e2] = cvt_pk_bf16(os[mm][0], os[mm][1]); }
                        }
#pragma unroll
                    for (int mm = 0; mm < 2; ++mm) {
                        const size_t off = (size_t)(row0 + ai * 128 + (2 * cp + mm) * 16) * 512 + kc;
                        *(u32x4*)(QD + off) = (u32x4){qd[mm][0], qd[mm][1], qd[mm][2], qd[mm][3]};
                        *(u32x4*)(KD + off) = (u32x4){kd[mm][0], kd[mm][1], kd[mm][2], kd[mm][3]};
                        *(u32x4*)(KS + off) = (u32x4){ks[mm][0], ks[mm][1], ks[mm][2], ks[mm][3]};
                    }
                    if (fr == 15) {
                        const int rc = (u.pm * 256 + ai * 128 + wr * 64 + cp * 32) >> 5;
                        float* bp = BL + (size_t)rc * 512 + kc;
                        *(f32x4*)bp = (f32x4){bl[0], bl[1], bl[2], bl[3]}; *(f32x4*)(bp + 4) = (f32x4){bl[4], bl[5], bl[6], bl[7]};
                    }
                }
        } else {
            const int t = (u.pn - 4) >> 1;
            bf16_t* dst = VV + (size_t)t * (size_t)(16u << 20);
            const int colb = ((u.pn - 4) & 1) * 256 + wc * 32 + 8 * fq;
#pragma unroll
            for (int ai = 0; ai < 2; ++ai)
#pragma unroll
                for (int m = 0; m < 4; ++m)
#pragma unroll
                    for (int bj = 0; bj < 2; ++bj) {
                        float v[8];
#pragma unroll
                        for (int n = 0; n < 2; ++n)
#pragma unroll
                            for (int e = 0; e < 4; ++e) { float x = acc[ai][bj][m][n][e];
                                if (t == 1) x = x * sigm(x);
                                else if (t == 3) { const float z = 1.5957691216f * (x + 0.044715f * x * x * x); x = x * sigm(z); }
                                v[4 * n + e] = x; }
                        const size_t off = (size_t)(row0 + ai * 128 + m * 16) * 512 + colb + bj * 128;
                        *(u32x4*)(dst + off) = (u32x4){cvt_pk_bf16(v[0], v[1]), cvt_pk_bf16(v[2], v[3]), cvt_pk_bf16(v[4], v[5]), cvt_pk_bf16(v[6], v[7])};
                    }
        }
    }
};

template <bool WRITE_B>
struct EpiRes {
    static constexpr bool PERM = true;
    const float* base; float* out; bf16_t* outb; float* part;
    __device__ __forceinline__ void operator()(const AccT& acc, const pg8::Unit& u, int wr, int wc, int fr, int fq) const {
        const int row0 = u.pm * 256 + wr * 64 + fr, colt = u.pn * 256 + wc * 32 + 8 * fq;
#pragma unroll
        for (int ai = 0; ai < 2; ++ai)
#pragma unroll
            for (int m = 0; m < 4; ++m) {
                const int row = row0 + ai * 128 + m * 16; float ss = 0.f;
#pragma unroll
                for (int bj = 0; bj < 2; ++bj) {
                    const size_t off = (size_t)row * DM + colt + bj * 128;
                    const f32x4 v0 = acc[ai][bj][m][0] + *(const f32x4*)(base + off), v1 = acc[ai][bj][m][1] + *(const f32x4*)(base + off + 4);
                    *(f32x4*)(out + off) = v0; *(f32x4*)(out + off + 4) = v1;
                    if (WRITE_B) *(u32x4*)(outb + off) = (u32x4){cvt_pk_bf16(v0[0], v0[1]), cvt_pk_bf16(v0[2], v0[3]), cvt_pk_bf16(v1[0], v1[1]), cvt_pk_bf16(v1[2], v1[3])};
                    ss += (v0[0] * v0[0] + v0[1] * v0[1]) + (v0[2] * v0[2] + v0[3] * v0[3]) + (v1[0] * v1[0] + v1[1] * v1[1]) + (v1[2] * v1[2] + v1[3] * v1[3]);
                }
                ss += __shfl_xor(ss, 16); ss += __shfl_xor(ss, 32);
                if (fq == 0) part[(size_t)row * 16 + u.pn * 4 + wc] = ss;
            }
    }
};

struct EpiG3 {
    static constexpr bool PERM = true;
    const float* part; bf16_t* ACT;
    __device__ __forceinline__ void operator()(const AccT& acc, const pg8::Unit& u, int wr, int wc, int fr, int fq) const {
        const int row0 = u.pm * 256 + wr * 64 + fr, col = u.pn * 128 + wc * 32 + 8 * fq;
#pragma unroll
        for (int ai = 0; ai < 2; ++ai)
#pragma unroll
            for (int m = 0; m < 4; ++m) {
                const int row = row0 + ai * 128 + m * 16;
                const f32x4* pp = (const f32x4*)(part + (size_t)row * 16);
                const f32x4 s4 = (pp[0] + pp[1]) + (pp[2] + pp[3]);
                const float rs = __builtin_amdgcn_rsqf(((s4[0] + s4[1]) + (s4[2] + s4[3])) * (1.f / DM) + EPS);
                float v[8];
#pragma unroll
                for (int n = 0; n < 2; ++n)
#pragma unroll
                    for (int e = 0; e < 4; ++e) { const float g = acc[ai][0][m][n][e] * rs, up = acc[ai][1][m][n][e] * rs; v[4 * n + e] = g * sigm(g) * up; }
                *(u32x4*)(ACT + (size_t)row * DFF + col) = (u32x4){cvt_pk_bf16(v[0], v[1]), cvt_pk_bf16(v[2], v[3]), cvt_pk_bf16(v[4], v[5]), cvt_pk_bf16(v[6], v[7])};
            }
    }
};

struct Args { const float* in[17]; float* out; unsigned char* ws; int ph_lo, ph_hi; };
enum { I_X = 0, I_MIXNW, I_WIN, I_HGLB, I_HGNW, I_CONVW, I_CONVB, I_WA, I_BA, I_WX, I_BX, I_LRUA, I_WOUT, I_FFNNW, I_WGU, I_WDN, I_FINW };

DI unsigned f2bf(float f) { unsigned u = __builtin_bit_cast(unsigned, f); return (u + 0x7fffu + ((u >> 16) & 1u)) >> 16; }
DI unsigned pk2(float lo, float hi) { return f2bf(lo) | (f2bf(hi) << 16); }
DI void p0_transpose_item(const float* W, int K, int N, bf16_t* WT, int kb, int n0, int dst_n0, const float* kscale, LAS float* scr, int lane) {
    const int k0 = 64 * kb;
#pragma unroll 8
    for (int i = 0; i < 32; ++i) { const int kk = 2 * i + (lane >> 5); float w = W[(size_t)(k0 + kk) * N + n0 + (lane & 31)]; if (kscale) w *= kscale[k0 + kk]; scr[kk * 33 + (lane & 31)] = w; }
    asm volatile("s_waitcnt lgkmcnt(0)" ::: "memory");
    const int c = lane & 7;
#pragma unroll
    for (int j = 0; j < 4; ++j) { const int n = (lane >> 3) + 8 * j; const LAS float* s = scr + (8 * c) * 33 + n;
        u32x4 o; o.x = pk2(s[0 * 33], s[1 * 33]); o.y = pk2(s[2 * 33], s[3 * 33]); o.z = pk2(s[4 * 33], s[5 * 33]); o.w = pk2(s[6 * 33], s[7 * 33]);
        *(u32x4*)(WT + (size_t)(dst_n0 + n) * K + k0 + 8 * c) = o; }
    asm volatile("s_waitcnt lgkmcnt(0)" ::: "memory");
}
DI void p0_prologue(const Args& a, LAS unsigned char* lds, int wave, int lane) {
    LAS float* scr = (LAS float*)(lds + wave * 16384);
    const int gw = blockIdx.x * 8 + wave, NGW = gridDim.x * 8;
    unsigned char* ws = a.ws;
    constexpr int I_IN = (DM / 64) * (DIN / 32), I_OUT = (DM / 64) * (DM / 32), I_GU = (DM / 64) * (NGU / 32), I_DN = (DFF / 64) * (DM / 32);
    for (int it = gw; it < I_IN + I_OUT + I_GU + I_DN; it += NGW) {
        int r = it;
        if (r < I_IN) { const int nblk = DIN / 32, kb = r / nblk, n0 = 32 * (r % nblk); int d;
            if (n0 < 512) d = 256 * (n0 >> 7) + (n0 & 127); else if (n0 < 1024) { const int x = n0 - 512; d = 256 * (x >> 7) + 128 + (x & 127); } else d = n0;
            p0_transpose_item(a.in[I_WIN], DM, DIN, (bf16_t*)(ws + WS_WIN), kb, n0, d, nullptr, scr, lane); continue; }
        r -= I_IN;
        if (r < I_OUT) { const int nblk = DM / 32, kb = r / nblk, n0 = 32 * (r % nblk);
            p0_transpose_item(a.in[I_WOUT], DM, DM, (bf16_t*)(ws + WS_WOUT), kb, n0, n0, nullptr, scr, lane); continue; }
        r -= I_OUT;
        if (r < I_GU) { const int nblk = NGU / 32, kb = r / nblk, n0 = 32 * (r % nblk); int d;
            if (n0 < DFF) d = 256 * (n0 >> 7) + (n0 & 127); else { const int x = n0 - DFF; d = 256 * (x >> 7) + 128 + (x & 127); }
            p0_transpose_item(a.in[I_WGU], DM, NGU, (bf16_t*)(ws + WS_WGU), kb, n0, d, a.in[I_FFNNW], scr, lane); continue; }
        r -= I_GU;
        { const int nblk = DM / 32, kb = r / nblk, n0 = 32 * (r % nblk);
            p0_transpose_item(a.in[I_WDN], DFF, DM, (bf16_t*)(ws + WS_WDN), kb, n0, n0, nullptr, scr, lane); }
    }
    const float* x = a.in[I_X]; const float* nw = a.in[I_MIXNW]; bf16_t* XN = (bf16_t*)(ws + WS_XN);
    f32x4 w4[4];
#pragma unroll
    for (int j = 0; j < 4; ++j) w4[j] = ((const f32x4*)nw)[lane + 64 * j];
    for (int m = gw; m < M; m += NGW) {
        const f32x4* xr = (const f32x4*)(x + (size_t)m * DM) + lane;
        f32x4 v[4]; float s = 0.f;
#pragma unroll
        for (int j = 0; j < 4; ++j) { v[j] = xr[64 * j]; s += (v[j][0] * v[j][0] + v[j][1] * v[j][1]) + (v[j][2] * v[j][2] + v[j][3] * v[j][3]); }
        const float rstd = __builtin_amdgcn_rsqf(wave_sum(s) * (1.f / DM) + EPS);
        u32x2* o8 = (u32x2*)(XN + (size_t)m * DM) + lane;
#pragma unroll
        for (int j = 0; j < 4; ++j) { const f32x4 y = v[j] * rstd * w4[j]; o8[64 * j] = (u32x2){cvt_pk_bf16(y[0], y[1]), cvt_pk_bf16(y[2], y[3])}; }
    }
}

#define MFMA16(a, b, c) __builtin_amdgcn_mfma_f32_16x16x32_bf16((a), (b), (c), 0, 0, 0)
template <bool PC>
DI void hgrn_unit(LAS unsigned char* lds, const Args& a, int bh, int sc, int tid, int wid, int lane) {
    unsigned char* ws = a.ws;
    const bf16_t* QD = (const bf16_t*)(ws + WS_QD); const bf16_t* KD = (const bf16_t*)(ws + WS_KD); const bf16_t* KS = (const bf16_t*)(ws + WS_KS);
    const bf16_t* VV = (const bf16_t*)(ws + WS_VV); const bf16_t* GS = (const bf16_t*)(ws + WS_GS); bf16_t* MIXED = (bf16_t*)(ws + WS_MIXED);
    const float* BL = (const float*)(ws + WS_BL); float* SA = (float*)(ws + WS_SA); float* BLS = (float*)(ws + WS_BLS);
    const int b = bh >> 2, h = bh & 3, colb = h * 128, r = lane & 15, q = lane >> 4;
    LAS bf16_t* Qd = (LAS bf16_t*)lds; LAS bf16_t* Kd = (LAS bf16_t*)(lds + 8704); LAS bf16_t* Kst = (LAS bf16_t*)(lds + 17408); LAS bf16_t* Vt = (LAS bf16_t*)(lds + 27648);
    LAS bf16_t* St = (LAS bf16_t*)(lds + 37888); LAS float* RS = (LAS float*)(lds + 72704);
    const size_t row_base = (size_t)b * SEQ + (size_t)sc * 512;
    f32x4 S[8];
#pragma unroll
    for (int kb = 0; kb < 8; ++kb) S[kb] = (f32x4){0.f, 0.f, 0.f, 0.f};
    if (PC) {
        for (int sp = 0; sp < sc; ++sp) {
            const float* sa = SA + ((size_t)(bh * 8 + sp) * 8 + wid) * 2048; const float* bs = BLS + (size_t)(bh * 8 + sp) * 128;
#pragma unroll
            for (int kb = 0; kb < 8; ++kb) { const f32x4 d = *(const f32x4*)(bs + 16 * kb + 4 * q); const f32x4 v = *(const f32x4*)(sa + (kb * 64 + lane) * 4);
                S[kb] = (f32x4){S[kb][0] * fexp(d[0]) + v[0], S[kb][1] * fexp(d[1]) + v[1], S[kb][2] * fexp(d[2]) + v[2], S[kb][3] * fexp(d[3]) + v[3]}; }
        }
#pragma unroll
        for (int kb = 0; kb < 8; ++kb) *(LAS u32x2*)(St + (16 * wid + r) * 136 + 16 * kb + 4 * q) = (u32x2){cvt_pk_bf16(S[kb][0], S[kb][1]), cvt_pk_bf16(S[kb][2], S[kb][3])};
    }
    float blsum = 0.f;
    const int lr = tid & 31, lc = tid >> 5;
    u32x4 gq, gk, gs, gv;
    { const size_t off = (row_base + lr) * 512 + colb + lc * 8;
      if (PC) { gq = *(const u32x4*)(QD + off); gk = *(const u32x4*)(KD + off); }
      gs = *(const u32x4*)(KS + off); gv = *(const u32x4*)(VV + off); }
    f32x4 nwv = (f32x4){0.f, 0.f, 0.f, 0.f};
    if (PC) nwv = *(const f32x4*)(a.in[I_HGNW] + 16 * wid + 4 * q);
    for (int c = 0; c < 16; ++c) {
        __syncthreads();
        if (PC) { *(LAS u32x4*)(Qd + lr * 136 + lc * 8) = gq; *(LAS u32x4*)(Kd + lr * 136 + lc * 8) = gk; }
#pragma unroll
        for (int j = 0; j < 4; ++j) {
            Kst[(lc * 8 + 2 * j) * 40 + lr] = (bf16_t)(gs[j] & 0xffffu); Kst[(lc * 8 + 2 * j + 1) * 40 + lr] = (bf16_t)(gs[j] >> 16);
            Vt[(lc * 8 + 2 * j) * 40 + lr] = (bf16_t)(gv[j] & 0xffffu); Vt[(lc * 8 + 2 * j + 1) * 40 + lr] = (bf16_t)(gv[j] >> 16);
        }
        __syncthreads();
        if (c + 1 < 16) { const size_t off = (row_base + (c + 1) * 32 + lr) * 512 + colb + lc * 8;
            if (PC) { gq = *(const u32x4*)(QD + off); gk = *(const u32x4*)(KD + off); }
            gs = *(const u32x4*)(KS + off); gv = *(const u32x4*)(VV + off); }
        const size_t chunk_g = (row_base >> 5) + c;
        const float* blp = BL + chunk_g * 512 + colb;
        f32x4 dk[8];
#pragma unroll
        for (int kb = 0; kb < 8; ++kb) dk[kb] = *(const f32x4*)(blp + 16 * kb + 4 * q);
        if (!PC) { if (tid < 128) blsum += blp[tid]; }
        f32x4 o[2];
        if (PC) {
            bf16x8 qf[2][4];
#pragma unroll
            for (int tb = 0; tb < 2; ++tb)
#pragma unroll
                for (int ks = 0; ks < 4; ++ks) qf[tb][ks] = *(const LAS bf16x8*)(Qd + (16 * tb + r) * 136 + 32 * ks + 8 * q);
            f32x4 p00 = (f32x4){0.f, 0.f, 0.f, 0.f}, p01 = p00, p11 = p00;
#pragma unroll
            for (int ks = 0; ks < 4; ++ks) {
                const bf16x8 a0 = *(const LAS bf16x8*)(Kd + r * 136 + 32 * ks + 8 * q), a1 = *(const LAS bf16x8*)(Kd + (16 + r) * 136 + 32 * ks + 8 * q);
                p00 = MFMA16(a0, qf[0][ks], p00); p01 = MFMA16(a0, qf[1][ks], p01); p11 = MFMA16(a1, qf[1][ks], p11);
            }
#pragma unroll
            for (int i = 0; i < 4; ++i) if (r < 4 * q + i) { p00[i] = 0.f; p11[i] = 0.f; }
            u32x4 b0w = (u32x4){cvt_pk_bf16(p00[0], p00[1]), cvt_pk_bf16(p00[2], p00[3]), 0u, 0u};
            u32x4 b1w = (u32x4){cvt_pk_bf16(p01[0], p01[1]), cvt_pk_bf16(p01[2], p01[3]), cvt_pk_bf16(p11[0], p11[1]), cvt_pk_bf16(p11[2], p11[3])};
            const bf16x8 pb0 = __builtin_bit_cast(bf16x8, b0w), pb1 = __builtin_bit_cast(bf16x8, b1w);
            const u32x2 v0 = *(const LAS u32x2*)(Vt + (16 * wid + r) * 40 + 4 * q), v1 = *(const LAS u32x2*)(Vt + (16 * wid + r) * 40 + 16 + 4 * q);
            const bf16x8 av = __builtin_bit_cast(bf16x8, (u32x4){v0[0], v0[1], v1[0], v1[1]});
            o[0] = MFMA16(av, pb0, ((f32x4){0.f, 0.f, 0.f, 0.f})); o[1] = MFMA16(av, pb1, ((f32x4){0.f, 0.f, 0.f, 0.f}));
#pragma unroll
            for (int ks = 0; ks < 4; ++ks) { const bf16x8 sa = *(const LAS bf16x8*)(St + (16 * wid + r) * 136 + 32 * ks + 8 * q);
                o[0] = MFMA16(sa, qf[0][ks], o[0]); o[1] = MFMA16(sa, qf[1][ks], o[1]); }
#pragma unroll
            for (int tb = 0; tb < 2; ++tb) { float ss = (o[tb][0] * o[tb][0] + o[tb][1] * o[tb][1]) + (o[tb][2] * o[tb][2] + o[tb][3] * o[tb][3]);
                ss += __shfl_xor(ss, 16); ss += __shfl_xor(ss, 32); if (q == 0) RS[wid * 32 + 16 * tb + r] = ss; }
        }
        { const bf16x8 bv = *(const LAS bf16x8*)(Vt + (16 * wid + r) * 40 + 8 * q);
#pragma unroll
          for (int kb = 0; kb < 8; ++kb) { const bf16x8 ak = *(const LAS bf16x8*)(Kst + (16 * kb + r) * 40 + 8 * q);
              const f32x4 sd = (f32x4){S[kb][0] * fexp(dk[kb][0]), S[kb][1] * fexp(dk[kb][1]), S[kb][2] * fexp(dk[kb][2]), S[kb][3] * fexp(dk[kb][3])};
              S[kb] = MFMA16(ak, bv, sd); }
          if (PC) {
#pragma unroll
              for (int kb = 0; kb < 8; ++kb) *(LAS u32x2*)(St + (16 * wid + r) * 136 + 16 * kb + 4 * q) = (u32x2){cvt_pk_bf16(S[kb][0], S[kb][1]), cvt_pk_bf16(S[kb][2], S[kb][3])};
          } }
        if (PC) {
            __syncthreads();
#pragma unroll
            for (int tb = 0; tb < 2; ++tb) { const int t = 16 * tb + r; float tot = 0.f;
#pragma unroll
                for (int w = 0; w < 8; ++w) tot += RS[w * 32 + t];
                const float rstd = __builtin_amdgcn_rsqf(tot * (1.f / 128.f) + EPS);
                const size_t row = row_base + c * 32 + t;
                const u32x2 g2 = *(const u32x2*)(GS + row * 512 + colb + 16 * wid + 4 * q);
                const float y0 = o[tb][0] * rstd * nwv[0] * bflo(g2[0]), y1 = o[tb][1] * rstd * nwv[1] * bfhi(g2[0]), y2 = o[tb][2] * rstd * nwv[2] * bflo(g2[1]), y3 = o[tb][3] * rstd * nwv[3] * bfhi(g2[1]);
                *(u32x2*)(MIXED + row * DM + colb + 16 * wid + 4 * q) = (u32x2){cvt_pk_bf16(y0, y1), cvt_pk_bf16(y2, y3)}; }
        }
    }
    if (!PC) {
        float* sa = SA + ((size_t)(bh * 8 + sc) * 8 + wid) * 2048;
#pragma unroll
        for (int kb = 0; kb < 8; ++kb) *(f32x4*)(sa + (kb * 64 + lane) * 4) = S[kb];
        if (tid < 128) BLS[(size_t)(bh * 8 + sc) * 128 + tid] = blsum;
    }
    __syncthreads();
}

template <bool PC>
DI void lru_unit(LAS unsigned char* lds, const Args& a, int b, int n, int seg, int tid, int wid, int lane) {
    unsigned char* ws = a.ws;
    const bf16_t* LX = (const bf16_t*)(ws + WS_LX); const bf16_t* LG = (const bf16_t*)(ws + WS_LG); bf16_t* MIXED = (bf16_t*)(ws + WS_MIXED); float* LRT = (float*)(ws + WS_LRT);
    LAS bf16_t* Xs = (LAS bf16_t*)lds; LAS bf16_t* XCb = (LAS bf16_t*)(lds + 19456); LAS float* XCf = (LAS float*)(lds + 37888);
    const int r = lane & 15, q = lane >> 4, eb = wid & 3, th = wid >> 2, ch = n * 64 + eb * 16 + r;
    bf16x8 wa_f[2], wx_f[2];
    { const float* wa = a.in[I_WA] + (size_t)n * 4096; const float* wx = a.in[I_WX] + (size_t)n * 4096;
#pragma unroll
      for (int ks = 0; ks < 2; ++ks) { unsigned pa[4], px[4];
#pragma unroll
          for (int j2 = 0; j2 < 4; ++j2) { const int d = 32 * ks + 8 * q + 2 * j2;
              pa[j2] = pk2(wa[d * 64 + eb * 16 + r], wa[(d + 1) * 64 + eb * 16 + r]); px[j2] = pk2(wx[d * 64 + eb * 16 + r], wx[(d + 1) * 64 + eb * 16 + r]); }
          wa_f[ks] = __builtin_bit_cast(bf16x8, (u32x4){pa[0], pa[1], pa[2], pa[3]}); wx_f[ks] = __builtin_bit_cast(bf16x8, (u32x4){px[0], px[1], px[2], px[3]}); } }
    const float ba = a.in[I_BA][ch], bx = a.in[I_BX][ch];
    const float ap = a.in[I_LRUA][ch];
    const float sp8 = 8.f * (ap > 15.f ? fexp(-ap) : __logf(1.f + fexp(-ap)));
    const int seg2 = seg * 2 + th;
    float carry = 0.f, Atot = 1.f, Btot = 0.f;
    if (PC) { for (int s = 0; s < seg2; ++s) { const f32x2 ab = *(const f32x2*)(LRT + ((size_t)(b * 16 + s) * 512 + ch) * 2); carry = ab[0] * carry + ab[1]; } }
    const int cc = tid & 7;
    const float* cw = a.in[I_CONVW] + n * 64 + cc * 8; const float* cb = a.in[I_CONVB] + n * 64 + cc * 8;
    for (int j = 0; j < 4; ++j) {
        __syncthreads();
        for (int it = tid; it < 1072; it += 512) {
            const int th2 = it >= 536, rem = it - th2 * 536, row = rem >> 3, c8 = rem & 7;
            const int tok = seg * 512 + th2 * 256 + j * 64 + row - 3;
            u32x4 v = (u32x4){0u, 0u, 0u, 0u};
            if (tok >= 0) v = *(const u32x4*)(LX + ((size_t)b * SEQ + tok) * 512 + n * 64 + c8 * 8);
            *(LAS u32x4*)(Xs + (th2 * 67 + row) * 72 + c8 * 8) = v;
        }
        __syncthreads();
#pragma unroll
        for (int k = 0; k < 2; ++k) {
            const int it = tid + 512 * k, th2 = it >> 9, t = (it >> 3) & 63;
            float xc[8];
#pragma unroll
            for (int c = 0; c < 8; ++c) xc[c] = cb[c];
#pragma unroll
            for (int tap = 0; tap < 4; ++tap) { const u32x4 xv = *(const LAS u32x4*)(Xs + (th2 * 67 + t + tap) * 72 + cc * 8);
                const f32x4 w0 = *(const f32x4*)(cw + tap * 512), w1 = *(const f32x4*)(cw + tap * 512 + 4);
                xc[0] += bflo(xv[0]) * w0[0]; xc[1] += bfhi(xv[0]) * w0[1]; xc[2] += bflo(xv[1]) * w0[2]; xc[3] += bfhi(xv[1]) * w0[3];
                xc[4] += bflo(xv[2]) * w1[0]; xc[5] += bfhi(xv[2]) * w1[1]; xc[6] += bflo(xv[3]) * w1[2]; xc[7] += bfhi(xv[3]) * w1[3]; }
            *(LAS u32x4*)(XCb + (th2 * 64 + t) * 72 + cc * 8) = (u32x4){cvt_pk_bf16(xc[0], xc[1]), cvt_pk_bf16(xc[2], xc[3]), cvt_pk_bf16(xc[4], xc[5]), cvt_pk_bf16(xc[6], xc[7])};
            *(LAS f32x4*)(XCf + (th2 * 64 + t) * 68 + cc * 8) = (f32x4){xc[0], xc[1], xc[2], xc[3]};
            *(LAS f32x4*)(XCf + (th2 * 64 + t) * 68 + cc * 8 + 4) = (f32x4){xc[4], xc[5], xc[6], xc[7]};
        }
        __syncthreads();
        for (int tb = 0; tb < 4; ++tb) {
            f32x4 R = (f32x4){0.f, 0.f, 0.f, 0.f}, I = R;
#pragma unroll
            for (int ks = 0; ks < 2; ++ks) { const bf16x8 af = *(const LAS bf16x8*)(XCb + (th * 64 + 16 * tb + r) * 72 + 32 * ks + 8 * q);
                R = MFMA16(af, wa_f[ks], R); I = MFMA16(af, wx_f[ks], I); }
            float av[4], bv[4];
            const size_t tok0 = (size_t)b * SEQ + seg * 512 + th * 256 + j * 64 + 16 * tb + 4 * q;
#pragma unroll
            for (int i = 0; i < 4; ++i) {
                const float xcv = XCf[(th * 64 + 16 * tb + 4 * q + i) * 68 + eb * 16 + r];
                const float rg = sigm(R[i] + ba), ig = sigm(I[i] + bx);
                const float aa = fexp(-sp8 * rg);
                av[i] = aa; bv[i] = __builtin_sqrtf(fmaxf(1.f - aa * aa, 0.f)) * ig * xcv;
            }
            float Al = av[0], Bl = bv[0];
#pragma unroll
            for (int i = 1; i < 4; ++i) { Bl = av[i] * Bl + bv[i]; Al *= av[i]; }
            float Ai = Al, Bi = Bl;
            { const float Ap = __shfl_up(Ai, 16), Bp = __shfl_up(Bi, 16); if (q >= 1) { Bi = Ai * Bp + Bi; Ai = Ai * Ap; } }
            { const float Ap = __shfl_up(Ai, 32), Bp = __shfl_up(Bi, 32); if (q >= 2) { Bi = Ai * Bp + Bi; Ai = Ai * Ap; } }
            float Ae = __shfl_up(Ai, 16), Be = __shfl_up(Bi, 16); if (q == 0) { Ae = 1.f; Be = 0.f; }
            const float A3 = __shfl(Ai, r + 48), B3 = __shfl(Bi, r + 48);
            if (PC) {
                float hcur = Ae * carry + Be;
#pragma unroll
                for (int i = 0; i < 4; ++i) { hcur = av[i] * hcur + bv[i];
                    const float gg = bf2f(LG[(tok0 + i) * 512 + ch]);
                    MIXED[(tok0 + i) * DM + 512 + ch] = (bf16_t)f2bf(hcur * gg); }
                carry = A3 * carry + B3;
            } else { Btot = A3 * Btot + B3; Atot *= A3; }
        }
    }
    if (!PC) { if (q == 0) *(f32x2*)(LRT + ((size_t)(b * 16 + seg2) * 512 + ch) * 2) = (f32x2){Atot, Btot}; }
    __syncthreads();
}

#define XB_TMO      128
#define XB_XCNT(j)  (256  + 64 * (j))
#define XB_XSUB(j)  (1280 + 64 * (j))
#define XB_XGEN(j)  (2304 + 64 * (j))
#define XB_TOP      3328
#define XB_TOPGEN   3392
#define XCD_BAR_WORDS 3456
#define XB_SPIN_CAP (1u << 18)

__device__ __forceinline__ unsigned xb_ld(unsigned* p)              { return __hip_atomic_load(p, __ATOMIC_RELAXED, __HIP_MEMORY_SCOPE_AGENT); }
__device__ __forceinline__ unsigned xb_add(unsigned* p, unsigned v) { return __hip_atomic_fetch_add(p, v, __ATOMIC_RELAXED, __HIP_MEMORY_SCOPE_AGENT); }
__device__ __forceinline__ unsigned xb_xcc_id() { return (unsigned)__builtin_amdgcn_s_getreg((3 << 11) | 20) & 0xFu; }
#define XB_SPIN(cond, bar) do { unsigned _sp = 0; while (cond) { __builtin_amdgcn_s_sleep(1); \
    if ((++_sp & 255u) == 0u) { if (xb_ld(&(bar)[XB_TMO])) break; if (_sp > XB_SPIN_CAP) { atomicAdd(&(bar)[XB_TMO], 1u); break; } } } } while (0)

struct XcdBarrier {
    unsigned* bar; unsigned x;
    volatile LAS unsigned* st;
};

__device__ __forceinline__ XcdBarrier xcd_barrier_post(unsigned* bar, volatile LAS unsigned* st) {
    XcdBarrier b; b.bar = bar; b.x = xb_xcc_id(); b.st = st;
    if (threadIdx.x == 0) (void)xb_add(&bar[XB_XCNT(b.x)], 1u);
    return b;
}
__device__ __forceinline__ void xcd_barrier_complete(unsigned* bar, unsigned x, unsigned& nloc, unsigned& nx) {
    const unsigned G = gridDim.x * gridDim.y * gridDim.z;
    unsigned sum, cnt, mine, sp = 0u;
    for (;;) {
        sum = 0u; cnt = 0u; mine = 0u;
#pragma unroll
        for (unsigned j = 0; j < 16; ++j) { const unsigned c = xb_ld(&bar[XB_XCNT(j)]); sum += c; cnt += (c > 0u) ? 1u : 0u; mine = (j == x) ? c : mine; }
        if (sum == G) break;
        __builtin_amdgcn_s_sleep(1);
        if ((++sp & 255u) == 0u) { if (xb_ld(&bar[XB_TMO])) break; if (sp > XB_SPIN_CAP) { atomicAdd(&bar[XB_TMO], 1u); break; } }
    }
    nloc = mine > 0u ? mine : 1u; nx = cnt > 0u ? cnt : 1u;
}

__device__ __forceinline__ void xcd_barrier(const XcdBarrier& b) {
    asm volatile("s_waitcnt vmcnt(0)" ::: "memory");
    __syncthreads();
    if (threadIdx.x == 0) {
        unsigned* bar = b.bar;
        __builtin_amdgcn_s_waitcnt(0);
        unsigned nloc = b.st[0], nx = b.st[1];
        if (nloc == 0u) { xcd_barrier_complete(bar, b.x, nloc, nx); b.st[0] = nloc; b.st[1] = nx; }
        const unsigned old = xb_add(&bar[XB_XSUB(b.x)], 1u);
        const unsigned gen = old / nloc;
        if (old + 1u == (gen + 1u) * nloc) {
            __builtin_amdgcn_fence(__ATOMIC_RELEASE, "agent");
            asm volatile("s_waitcnt vmcnt(0)" ::: "memory");
            const unsigned og = xb_add(&bar[XB_TOP], 1u);
            const unsigned tg = og / nx;
            if (og + 1u == (tg + 1u) * nx) xb_add(&bar[XB_TOPGEN], 1u);
            else XB_SPIN(xb_ld(&bar[XB_TOPGEN]) == tg, bar);
            __builtin_amdgcn_fence(__ATOMIC_ACQUIRE, "agent");
            xb_add(&bar[XB_XGEN(b.x)], 1u);
            asm volatile("s_waitcnt vmcnt(0)" ::: "memory");
        } else {
            XB_SPIN(xb_ld(&bar[XB_XGEN(b.x)]) == gen, bar);
            __builtin_amdgcn_fence(__ATOMIC_ACQUIRE, "agent");
            asm volatile("s_waitcnt vmcnt(0)" ::: "memory");
        }
    }
    __syncthreads();
}

__global__ void __launch_bounds__(512, 2) fwd_megakernel(Args a) {
    extern __shared__ __attribute__((aligned(16))) unsigned char lds_raw[];
    LAS unsigned char* lds = (LAS unsigned char*)lds_raw;
    cg::grid_group grid = cg::this_grid();
    const int tid = threadIdx.x, lane = tid & 63, wid = __builtin_amdgcn_readfirstlane(tid >> 6);
    const int lo = a.ph_lo, hi = a.ph_hi, G = gridDim.x;
    unsigned char* ws = a.ws;
#define IN(k) (lo <= (k) && (k) < hi)
#define SEAM(k) do { if (IN(k) && IN((k) + 1)) xcd_barrier(bar); } while (0)
    volatile LAS unsigned* misc = (volatile LAS unsigned*)(lds + LDS_MISC_OFF);
    if (tid < 16) misc[tid] = 0u;
    __syncthreads();
    XcdBarrier bar = xcd_barrier_post((unsigned*)(ws + WS_CTL), misc);
    if (MK_N_LAUNCHES == 1) grid.sync();
    if (IN(0)) { p0_prologue(a, lds, wid, lane); }
    SEAM(0);
    if (IN(1)) {
        pg8::Gemm g{(const bf16_t*)(ws + WS_XN), (const bf16_t*)(ws + WS_WIN), M, DIN, DM}; pg8::StaticOrder S; S.init(M, DIN, G, (int)blockIdx.x);
        EpiG1 E{(bf16_t*)(ws + WS_QD), (bf16_t*)(ws + WS_KD), (bf16_t*)(ws + WS_KS), (bf16_t*)(ws + WS_VV), (bf16_t*)(ws + WS_GS), (bf16_t*)(ws + WS_LX), (bf16_t*)(ws + WS_LG), (float*)(ws + WS_BL), a.in[I_HGLB]};
        pg8::gemm_phase<EpiG1, true>(lds, g, S, E);
    }
    SEAM(1);
    if (IN(2)) {
        for (int u = blockIdx.x; u < 224; u += G) hgrn_unit<false>(lds, a, u / 7, u % 7, tid, wid, lane);
        for (int u = blockIdx.x; u < 512; u += G) lru_unit<false>(lds, a, u >> 6, (u >> 3) & 7, u & 7, tid, wid, lane);
    }
    SEAM(2);
    if (IN(3)) {
        for (int u = blockIdx.x; u < 256; u += G) hgrn_unit<true>(lds, a, u >> 3, u & 7, tid, wid, lane);
        for (int u = blockIdx.x; u < 512; u += G) lru_unit<true>(lds, a, u >> 6, (u >> 3) & 7, u & 7, tid, wid, lane);
    }
    SEAM(3);
    if (IN(4)) {
        pg8::Gemm g{(const bf16_t*)(ws + WS_MIXED), (const bf16_t*)(ws + WS_WOUT), M, DM, DM}; pg8::StaticOrder S; S.init(M, DM, G, (int)blockIdx.x);
        EpiRes<true> E{a.in[I_X], (float*)(ws + WS_H1), (bf16_t*)(ws + WS_H1B), (float*)(ws + WS_PART1)};
        pg8::gemm_phase<EpiRes<true>, true>(lds, g, S, E);
    }
    SEAM(4);
    if (IN(5)) {
        pg8::Gemm g{(const bf16_t*)(ws + WS_H1B), (const bf16_t*)(ws + WS_WGU), M, NGU, DM}; pg8::StaticOrder S; S.init(M, NGU, G, (int)blockIdx.x);
        EpiG3 E{(const float*)(ws + WS_PART1), (bf16_t*)(ws + WS_ACT)};
        pg8::gemm_phase<EpiG3, true>(lds, g, S, E);
    }
    SEAM(5);
    if (IN(6)) {
        pg8::Gemm g{(const bf16_t*)(ws + WS_ACT), (const bf16_t*)(ws + WS_WDN), M, DM, DFF}; pg8::StaticOrder S; S.init(M, DM, G, (int)blockIdx.x);
        EpiRes<false> E{(const float*)(ws + WS_H1), a.out, nullptr, (float*)(ws + WS_PART2)};
        pg8::gemm_phase<EpiRes<false>, true>(lds, g, S, E);
    }
    SEAM(6);
    if (IN(7)) {
        const float* part = (const float*)(ws + WS_PART2); const float* fw = a.in[I_FINW];
        f32x4 w4[4];
#pragma unroll
        for (int j = 0; j < 4; ++j) w4[j] = ((const f32x4*)fw)[lane + 64 * j];
        for (int m = blockIdx.x * 8 + wid; m < M; m += G * 8) {
            const float p = lane < 16 ? part[(size_t)m * 16 + lane] : 0.f;
            const float rstd = __builtin_amdgcn_rsqf(wave_sum(p) * (1.f / DM) + EPS);
            f32x4* xr = (f32x4*)(a.out + (size_t)m * DM) + lane;
#pragma unroll
            for (int j = 0; j < 4; ++j) xr[64 * j] = xr[64 * j] * rstd * w4[j];
        }
    }
#undef IN
#undef SEAM
}

extern "C" void kernel_launch(void* const* d_in, const int* in_sizes, int n_in, void* d_out, int out_size, void* d_ws, size_t ws_size, hipStream_t stream) {
    static int grid = 0;
    if (grid == 0) {
        if (n_in != 17 || out_size != M * DM || ws_size < WS_END) { fprintf(stderr, "kernel_launch: unexpected shapes (n_in %d, out %d, ws %zu)\n", n_in, out_size, ws_size); grid = -1; return; }
        int dev = 0, cus = 0, per_cu = 0;
        (void)hipGetDevice(&dev); (void)hipDeviceGetAttribute(&cus, hipDeviceAttributeMultiprocessorCount, dev);
        if (hipFuncSetAttribute((const void*)fwd_megakernel, hipFuncAttributeMaxDynamicSharedMemorySize, LDS_BYTES) != hipSuccess) { fprintf(stderr, "kernel_launch: hipFuncSetAttribute failed\n"); grid = -1; return; }
        if (hipOccupancyMaxActiveBlocksPerMultiprocessor(&per_cu, (const void*)fwd_megakernel, 512, LDS_BYTES) != hipSuccess || per_cu < 1) { fprintf(stderr, "kernel_launch: occupancy query says %d blocks/CU\n", per_cu); per_cu = 1; }
        (void)hipGetLastError();
        grid = cus * (per_cu < 1 ? 1 : 1);
        fprintf(stderr, "kernel_launch: grid %d (cus %d, per_cu %d)\n", grid, cus, per_cu);
    }
    if (grid < 0) return;
    if (hipMemsetAsync((char*)d_ws + WS_CTL, 0, CTL_ZERO_BYTES, stream) != hipSuccess) { fprintf(stderr, "kernel_launch: memset failed\n"); return; }
    Args a{};
    for (int i = 0; i < 17; ++i) a.in[i] = (const float*)d_in[i];
    a.out = (float*)d_out; a.ws = (unsigned char*)d_ws;
#if MK_N_LAUNCHES == 1
    a.ph_lo = 0; a.ph_hi = NPH;
    void* args[] = {&a};
    hipError_t e = hipLaunchCooperativeKernel((const void*)fwd_megakernel, dim3(grid), dim3(512), args, LDS_BYTES, stream);
    if (e != hipSuccess) fprintf(stderr, "cooperative launch failed: %s (grid %d)\n", hipGetErrorString(e), grid);
#else
    for (int p = 0; p < NPH; ++p) { a.ph_lo = p; a.ph_hi = p + 1; hipLaunchKernelGGL(fwd_megakernel, dim3(grid), dim3(512), LDS_BYTES, stream, a); }
#endif
}
```

```cpp
#include <hip/hip_runtime.h>
#include <hip/hip_cooperative_groups.h>
#include <cstdio>
#include <cstdint>
namespace cg = cooperative_groups;

#define LAS __attribute__((address_space(3)))
#define DI __device__ __forceinline__
typedef unsigned short bf16_t;
typedef short bf16x8 __attribute__((ext_vector_type(8)));
typedef float f32x4 __attribute__((ext_vector_type(4)));
typedef float f32x2 __attribute__((ext_vector_type(2)));
typedef unsigned u32x4 __attribute__((ext_vector_type(4)));
typedef unsigned u32x2 __attribute__((ext_vector_type(2)));

#ifndef MK_N_LAUNCHES
#define MK_N_LAUNCHES 1
#endif

constexpr int BATCH = 8, SEQ = 4096, DM = 1024, M = BATCH * SEQ;
constexpr int DIN = 3072, DFF = 2816, NGU = 2 * DFF;
constexpr float EPS = 1e-6f;
constexpr int NPH = 8;

constexpr size_t MiB = 1u << 20;
constexpr size_t WS_CTL = 0, CTL_ZERO_BYTES = 16384;
constexpr size_t WS_PART1 = 1 * MiB;
constexpr size_t WS_PART2 = 3 * MiB;
constexpr size_t WS_BL = 5 * MiB;
constexpr size_t WS_LRT = 7 * MiB;
constexpr size_t WS_BLS = 7 * MiB + 512 * 1024;
constexpr size_t WS_WIN = 8 * MiB, WS_WOUT = 14 * MiB, WS_WGU = 16 * MiB, WS_WDN = 27 * MiB;
constexpr size_t WS_SA = 34 * MiB;
constexpr size_t WS_XN = 50 * MiB;
constexpr size_t WS_MIXED = 114 * MiB;
constexpr size_t WS_ACT = 50 * MiB;
constexpr size_t WS_QD = 226 * MiB, WS_KD = 258 * MiB, WS_KS = 290 * MiB, WS_VV = 322 * MiB, WS_GS = 354 * MiB, WS_LX = 386 * MiB, WS_LG = 418 * MiB;
constexpr size_t WS_H1 = 226 * MiB;
constexpr size_t WS_H1B = 354 * MiB;
constexpr size_t WS_END = 450 * MiB;

constexpr int LDS_BYTES = 147456, LDS_MISC_OFF = 147456 - 64;

typedef __bf16 bf16x2v __attribute__((ext_vector_type(2)));
DI unsigned cvt_pk_bf16(float lo, float hi) { f32x2 v = {lo, hi}; bf16x2v b = __builtin_convertvector(v, bf16x2v); return __builtin_bit_cast(unsigned, b); }
DI float bf2f(unsigned short h) { return __builtin_bit_cast(float, (unsigned)h << 16); }
DI float bflo(unsigned w) { return __builtin_bit_cast(float, w << 16); }
DI float bfhi(unsigned w) { return __builtin_bit_cast(float, w & 0xffff0000u); }
DI float fexp(float x) { return __expf(x); }
DI float frcp(float x) { return __builtin_amdgcn_rcpf(x); }
DI float sigm(float x) { return frcp(1.f + fexp(-x)); }
DI float wave_sum(float v) {
#pragma unroll
    for (int o = 1; o < 64; o <<= 1) v += __shfl_xor(v, o);
    return v;
}
template <int D_> DI float dpp_shr(float v) { return __builtin_bit_cast(float, __builtin_amdgcn_update_dpp(0, __builtin_bit_cast(int, v), 0x110 + D_, 0xf, 0xf, true)); }
DI float scan16(float v) { v += dpp_shr<1>(v); v += dpp_shr<2>(v); v += dpp_shr<4>(v); v += dpp_shr<8>(v); return v; }
DI float row_last(float v) { return __shfl(v, 15, 16); }

namespace pg8 {
constexpr int BM = 256, BK = 64, HALF = 128, HTB = HALF * BK * 2, STAGE_BYTES = 8 * HTB, NXCD = 8, WGM = 8;
__host__ __device__ __forceinline__ int lds_byte(int r, int c) { const int st = (r >> 4) * 2 + (c >> 5), rr = r & 15, cc = c & 31, ob = rr * 64 + cc * 2; return st * 1024 + (ob ^ (((ob >> 9) & 1) << 5)); }
__host__ __device__ __forceinline__ void stage_rc(int b, int& R, int& C) { const int st = b / 1024, sb = b % 1024, swz = sb ^ (((sb >> 9) & 1) << 5); R = (st >> 1) * 16 + swz / 64; C = (st & 1) * 32 + (swz % 64) / 2; }
__host__ __device__ __forceinline__ int perm32(int rho) { const int n = rho >> 4, i = rho & 15; return 8 * (i >> 2) + 4 * n + (i & 3); }
struct Unit { int pm, pn; };
struct Gemm { const bf16_t* A; const bf16_t* Bt; int M, N, K; };
struct StaticOrder {
    int nM, nN, nwg, G, c;
    __host__ __device__ void init(int M_, int N_, int G_, int c_) { nM = M_ / BM; nN = N_ / BM; nwg = nM * nN; G = G_; c = c_; }
    __host__ __device__ bool next(int i, Unit& u) const {
        const long L = (long)i * G + c; if (L >= nwg) return false;
        int wgid = (int)L; { const int q = nwg / NXCD, r = nwg % NXCD, xcd = wgid % NXCD, off = wgid / NXCD; wgid = (xcd < r ? xcd * (q + 1) : r * (q + 1) + (xcd - r) * q) + off; }
        const int nig = WGM * nN, gid = wgid / nig, fm = gid * WGM, gsz = (nM - fm) < WGM ? (nM - fm) : WGM;
        u.pm = fm + ((wgid % nig) % gsz); u.pn = (wgid % nig) / gsz; return true;
    }
};

template <class Epi, bool ALIGN_EPI>
__device__ __forceinline__ void gemm_phase(LAS unsigned char* lds, const Gemm g, const StaticOrder& S, const Epi& E) {
    const int tid = threadIdx.x, wid = __builtin_amdgcn_readfirstlane(tid >> 6), lane = tid & 63, wr = wid >> 2, wc = wid & 3, fr = lane & 15, fq = lane >> 4;
    const int K = g.K, nt = K / BK;
    unsigned voffA[2], voffB[2];
#pragma unroll
    for (int i = 0; i < 2; ++i) { int R, C; stage_rc(tid * 16 + i * 8192, R, C); const int Rb = Epi::PERM ? ((R & ~31) + perm32(R & 31)) : R;
        voffA[i] = (unsigned)(R * K + C) * 2u; voffB[i] = (unsigned)(Rb * K + C) * 2u; }
    const size_t kstep = (size_t)(BK * 2);
    const size_t hstep = (size_t)HALF * K * 2;
    const size_t tstep = 2 * hstep;
    const unsigned ldsw = (unsigned)wid * 1024u;
    const int aoff = lds_byte(wr * 64 + fr, fq * 8), boff = lds_byte(wc * 32 + fr, fq * 8);
#define PG8_SA(b, h) (((b) * 2 + (h)) * HTB)
#define PG8_SB(b, h) ((4 + (b) * 2 + (h)) * HTB)
#define PG8_STAGE(bufoff, gbase, voff) do { _Pragma("unroll") for (int _i = 0; _i < 2; ++_i) \
        __builtin_amdgcn_global_load_lds((const unsigned*)((const char*)(gbase) + (voff)[_i]), (LAS unsigned*)(lds + (bufoff) + ldsw + _i * 8192), 16, 0, 0); } while (0)
#define PG8_LDA(dst, b, h) do { _Pragma("unroll") for (int m = 0; m < 4; ++m) _Pragma("unroll") for (int k = 0; k < 2; ++k) dst[m][k] = *(const LAS bf16x8*)(lds + PG8_SA(b, h) + aoff + m * 2048 + k * 1024); } while (0)
#define PG8_LDB(dst, b, h) do { _Pragma("unroll") for (int n = 0; n < 2; ++n) _Pragma("unroll") for (int k = 0; k < 2; ++k) dst[n][k] = *(const LAS bf16x8*)(lds + PG8_SB(b, h) + boff + n * 2048 + k * 1024); } while (0)
#define PG8_MMA(ai, bj, At, Bt) do { __builtin_amdgcn_s_setprio(1); _Pragma("unroll") for (int m = 0; m < 4; ++m) _Pragma("unroll") for (int n = 0; n < 2; ++n) _Pragma("unroll") for (int k = 0; k < 2; ++k) \
        acc[ai][bj][m][n] = __builtin_amdgcn_mfma_f32_16x16x32_bf16(Bt[n][k], At[m][k], acc[ai][bj][m][n], 0, 0, 0); __builtin_amdgcn_s_setprio(0); } while (0)
#define PG8_WAIT_V(n) asm volatile("s_waitcnt vmcnt(" #n ")" ::: "memory")
#define PG8_WAIT_L(n) asm volatile("s_waitcnt lgkmcnt(" #n ")" ::: "memory")
#define PG8_BAR __builtin_amdgcn_s_barrier()
#define PG8_SCHED __builtin_amdgcn_sched_barrier(0)
    Unit cur, nxt; int ui = 0;
    if (!S.next(0, cur)) return;
    f32x4 acc[2][2][4][2];
#pragma unroll
    for (int a = 0; a < 2; ++a)
#pragma unroll
        for (int b = 0; b < 2; ++b)
#pragma unroll
            for (int m = 0; m < 4; ++m)
#pragma unroll
                for (int n = 0; n < 2; ++n) acc[a][b][m][n] = (f32x4){0.f, 0.f, 0.f, 0.f};
    bf16x8 At[4][2], B0[2][2], B1[2][2];
    const char* cA = (const char*)g.A + (size_t)cur.pm * tstep; const char* cB = (const char*)g.Bt + (size_t)cur.pn * tstep;
    PG8_STAGE(PG8_SB(0, 0), cB, voffB); PG8_STAGE(PG8_SB(0, 1), cB + hstep, voffB); PG8_STAGE(PG8_SA(0, 0), cA, voffA); PG8_STAGE(PG8_SA(0, 1), cA + hstep, voffA);
    if (wr == 1) PG8_BAR;
    PG8_WAIT_V(2); PG8_BAR;
    PG8_STAGE(PG8_SB(1, 0), cB + kstep, voffB); PG8_STAGE(PG8_SA(1, 0), cA + kstep, voffA); PG8_STAGE(PG8_SB(1, 1), cB + hstep + kstep, voffB);
    PG8_WAIT_V(6); PG8_BAR;
    for (;;) {
        const bool has_next = S.next(ui + 1, nxt);
        const char* nA = has_next ? (const char*)g.A + (size_t)nxt.pm * tstep : cA; const char* nB = has_next ? (const char*)g.Bt + (size_t)nxt.pn * tstep : cB;
        for (int t = 0; t < nt; t += 2) {
            const bool last = (t == nt - 2);
            const char* a1 = cA + (size_t)(t + 1) * kstep;
            const char* a2 = last ? nA : cA + (size_t)(t + 2) * kstep; const char* b2 = last ? nB : cB + (size_t)(t + 2) * kstep;
            const char* a3 = a2 + kstep; const char* b3 = b2 + kstep;
            PG8_LDB(B0, 0, 0); PG8_LDB(B1, 0, 1); PG8_SCHED; PG8_LDA(At, 0, 0); PG8_STAGE(PG8_SA(1, 1), a1 + hstep, voffA);
            PG8_WAIT_V(8); PG8_WAIT_L(0); PG8_BAR; PG8_MMA(0, 0, At, B0); PG8_MMA(0, 1, At, B1); PG8_BAR; PG8_SCHED;
            PG8_LDA(At, 0, 1); PG8_STAGE(PG8_SB(0, 0), b2, voffB); PG8_STAGE(PG8_SB(0, 1), b2 + hstep, voffB); PG8_STAGE(PG8_SA(0, 0), a2, voffA);
            PG8_WAIT_V(8); PG8_WAIT_L(0); PG8_BAR; PG8_MMA(1, 0, At, B0); PG8_MMA(1, 1, At, B1); PG8_BAR; PG8_SCHED;
            PG8_LDB(B0, 1, 0); PG8_LDB(B1, 1, 1); PG8_SCHED; PG8_LDA(At, 1, 0); PG8_STAGE(PG8_SA(0, 1), a2 + hstep, voffA);
            PG8_WAIT_V(8); PG8_WAIT_L(0); PG8_BAR; PG8_MMA(0, 0, At, B0); PG8_MMA(0, 1, At, B1); PG8_BAR; PG8_SCHED;
            PG8_LDA(At, 1, 1); PG8_STAGE(PG8_SB(1, 0), b3, voffB); PG8_STAGE(PG8_SB(1, 1), b3 + hstep, voffB); PG8_STAGE(PG8_SA(1, 0), a3, voffA);
            PG8_WAIT_V(8); PG8_WAIT_L(0); PG8_BAR; PG8_MMA(1, 0, At, B0); PG8_MMA(1, 1, At, B1); PG8_BAR; PG8_SCHED;
        }
        if constexpr (ALIGN_EPI) { if (wr == 0) PG8_BAR; }
        E(acc, cur, wr, wc, fr, fq);
        if (!has_next) break;
#pragma unroll
        for (int a = 0; a < 2; ++a)
#pragma unroll
            for (int b = 0; b < 2; ++b)
#pragma unroll
                for (int m = 0; m < 4; ++m)
#pragma unroll
                    for (int n = 0; n < 2; ++n) acc[a][b][m][n] = (f32x4){0.f, 0.f, 0.f, 0.f};
        cur = nxt; cA = nA; cB = nB; ++ui;
        if constexpr (ALIGN_EPI) { if (wr == 1) PG8_BAR; }
    }
    PG8_WAIT_V(0);
    if constexpr (!ALIGN_EPI) { if (wr == 0) PG8_BAR; }
    PG8_BAR;
#undef PG8_SA
#undef PG8_SB
#undef PG8_STAGE
#undef PG8_LDA
#undef PG8_LDB
#undef PG8_MMA
#undef PG8_WAIT_V
#undef PG8_WAIT_L
#undef PG8_BAR
#undef PG8_SCHED
}
}

typedef f32x4 AccT[2][2][4][2];

struct EpiG1 {
    static constexpr bool PERM = true;
    bf16_t *QD, *KD, *KS, *VV, *GS, *LX, *LG; float* BL; const float* hg_lb;
    __device__ __forceinline__ void operator()(const AccT& acc, const pg8::Unit& u, int wr, int wc, int fr, int fq) const {
        const int row0 = u.pm * 256 + wr * 64 + fr;
        if (u.pn < 4) {
            const int h = u.pn, kc = h * 128 + wc * 32 + 8 * fq;
            float lbv[8], olb[8];
#pragma unroll
            for (int j = 0; j < 8; ++j) { const float a0 = hg_lb[kc + j], a1 = hg_lb[512 + kc + j]; lbv[j] = frcp(1.f + fexp(a1 - a0)); olb[j] = 1.f - lbv[j]; }
#pragma unroll
            for (int ai = 0; ai < 2; ++ai)
#pragma unroll
                for (int cp = 0; cp < 2; ++cp) {
                    unsigned qd[2][4], kd[2][4], ks[2][4]; float bl[8];
#pragma unroll
                    for (int n = 0; n < 2; ++n)
#pragma unroll
                        for (int e2 = 0; e2 < 2; ++e2) {
                            float oq[2][2], ok[2][2], os[2][2];
#pragma unroll
                            for (int ee = 0; ee < 2; ++ee) {
                                const int e = e2 * 2 + ee, j = 4 * n + e;
                                const float x0 = acc[ai][1][2 * cp][n][e], x1 = acc[ai][1][2 * cp + 1][n][e];
                                const float e0 = fexp(-x0), e1 = fexp(-x1), i0 = frcp(1.f + e0), i1 = frcp(1.f + e1);
                                const float f0 = lbv[j] + olb[j] * i0, f1 = lbv[j] + olb[j] * i1;
                                const float k0 = 1.f - f0, k1 = 1.f - f1;
                                const float p0 = scan16(__logf(f0)); const float t0 = row_last(p0);
                                const float p1 = scan16(__logf(f1)) + t0; const float bt = row_last(p1);
                                bl[j] = bt;
                                const float q0 = acc[ai][0][2 * cp][n][e], q1 = acc[ai][0][2 * cp + 1][n][e];
                                oq[0][ee] = q0 * sigm(q0) * fexp(p0); oq[1][ee] = q1 * sigm(q1) * fexp(p1);
                                ok[0][ee] = k0 * fexp(-p0); ok[1][ee] = k1 * fexp(-p1);
                                os[0][ee] = k0 * fexp(bt - p0); os[1][ee] = k1 * fexp(bt - p1);
                            }
#pragma unroll
                            for (int mm = 0; mm < 2; ++mm) { qd[mm][2 * n + e2] = cvt_pk_bf16(oq[mm][0], oq[mm][1]); kd[mm][2 * n + e2] = cvt_pk_bf16(ok[mm][0], ok[mm][1]); ks[mm][2 * n + e2] = cvt_pk_bf16(os[mm][0], os[mm][1]); }
                        }
#pragma unroll
                    for (int mm = 0; mm < 2; ++mm) {
                        const size_t off = (size_t)(row0 + ai * 128 + (2 * cp + mm) * 16) * 512 + kc;
                        *(u32x4*)(QD + off) = (u32x4){qd[mm][0], qd[mm][1], qd[mm][2], qd[mm][3]};
                        *(u32x4*)(KD + off) = (u32x4){kd[mm][0], kd[mm][1], kd[mm][2], kd[mm][3]};
                        *(u32x4*)(KS + off) = (u32x4){ks[mm][0], ks[mm][1], ks[mm][2], ks[mm][3]};
                    }
                    if (fr == 15) {
                        const int rc = (u.pm * 256 + ai * 128 + wr * 64 + cp * 32) >> 5;
                        float* bp = BL + (size_t)rc * 512 + kc;
                        *(f32x4*)bp = (f32x4){bl[0], bl[1], bl[2], bl[3]}; *(f32x4*)(bp + 4) = (f32x4){bl[4], bl[5], bl[6], bl[7]};
                    }
                }
        } else {
            const int t = (u.pn - 4) >> 1;
            bf16_t* dst = VV + (size_t)t * (size_t)(16u << 20);
            const int colb = ((u.pn - 4) & 1) * 256 + wc * 32 + 8 * fq;
#pragma unroll
            for (int ai = 0; ai < 2; ++ai)
#pragma unroll
                for (int m = 0; m < 4; ++m)
#pragma unroll
                    for (int bj = 0; bj < 2; ++bj) {
                        float v[8];
#pragma unroll
                        for (int n = 0; n < 2; ++n)
#pragma unroll
                            for (int e = 0; e < 4; ++e) { float x = acc[ai][bj][m][n][e];
                                if (t == 1) x = x * sigm(x);
                                else if (t == 3) { const float z = 1.5957691216f * (x + 0.044715f * x * x * x); x = x * sigm(z); }
                                v[4 * n + e] = x; }
                        const size_t off = (size_t)(row0 + ai * 128 + m * 16) * 512 + colb + bj * 128;
                        *(u32x4*)(dst + off) = (u32x4){cvt_pk_bf16(v[0], v[1]), cvt_pk_bf16(v[2], v[3]), cvt_pk_bf16(v[4], v[5]), cvt_pk_bf16(v[6], v[7])};
                    }
        }
    }
};

template <bool FIRST>
struct EpiRes {
    static constexpr bool PERM = true;
    const float* basef; const bf16_t* baseb; float* out; bf16_t* outb; float* part;
    __device__ __forceinline__ void operator()(const AccT& acc, const pg8::Unit& u, int wr, int wc, int fr, int fq) const {
        const int row0 = u.pm * 256 + wr * 64 + fr, colt = u.pn * 256 + wc * 32 + 8 * fq;
#pragma unroll
        for (int ai = 0; ai < 2; ++ai)
#pragma unroll
            for (int m = 0; m < 4; ++m) {
                const int row = row0 + ai * 128 + m * 16; float ss = 0.f;
#pragma unroll
                for (int bj = 0; bj < 2; ++bj) {
                    const size_t off = (size_t)row * DM + colt + bj * 128;
                    f32x4 b0, b1;
                    if (FIRST) { b0 = *(const f32x4*)(basef + off); b1 = *(const f32x4*)(basef + off + 4); }
                    else { const u32x4 w = *(const u32x4*)(baseb + off); b0 = (f32x4){bflo(w[0]), bfhi(w[0]), bflo(w[1]), bfhi(w[1])}; b1 = (f32x4){bflo(w[2]), bfhi(w[2]), bflo(w[3]), bfhi(w[3])}; }
                    const f32x4 v0 = acc[ai][bj][m][0] + b0, v1 = acc[ai][bj][m][1] + b1;
                    if (FIRST) *(u32x4*)(outb + off) = (u32x4){cvt_pk_bf16(v0[0], v0[1]), cvt_pk_bf16(v0[2], v0[3]), cvt_pk_bf16(v1[0], v1[1]), cvt_pk_bf16(v1[2], v1[3])};
                    else { *(f32x4*)(out + off) = v0; *(f32x4*)(out + off + 4) = v1; }
                    ss += (v0[0] * v0[0] + v0[1] * v0[1]) + (v0[2] * v0[2] + v0[3] * v0[3]) + (v1[0] * v1[0] + v1[1] * v1[1]) + (v1[2] * v1[2] + v1[3] * v1[3]);
                }
                ss += __shfl_xor(ss, 16); ss += __shfl_xor(ss, 32);
                if (fq == 0) part[(size_t)row * 16 + u.pn * 4 + wc] = ss;
            }
    }
};

struct EpiG3 {
    static constexpr bool PERM = true;
    const float* part; bf16_t* ACT;
    __device__ __forceinline__ void operator()(const AccT& acc, const pg8::Unit& u, int wr, int wc, int fr, int fq) const {
        const int row0 = u.pm * 256 + wr * 64 + fr, col = u.pn * 128 + wc * 32 + 8 * fq;
#pragma unroll
        for (int ai = 0; ai < 2; ++ai)
#pragma unroll
            for (int m = 0; m < 4; ++m) {
                const int row = row0 + ai * 128 + m * 16;
                const f32x4* pp = (const f32x4*)(part + (size_t)row * 16);
                const f32x4 s4 = (pp[0] + pp[1]) + (pp[2] + pp[3]);
                const float rs = __builtin_amdgcn_rsqf(((s4[0] + s4[1]) + (s4[2] + s4[3])) * (1.f / DM) + EPS);
                float v[8];
#pragma unroll
                for (int n = 0; n < 2; ++n)
#pragma unroll
                    for (int e = 0; e < 4; ++e) { const float g = acc[ai][0][m][n][e] * rs, up = acc[ai][1][m][n][e] * rs; v[4 * n + e] = g * sigm(g) * up; }
                *(u32x4*)(ACT + (size_t)row * DFF + col) = (u32x4){cvt_pk_bf16(v[0], v[1]), cvt_pk_bf16(v[2], v[3]), cvt_pk_bf16(v[4], v[5]), cvt_pk_bf16(v[6], v[7])};
            }
    }
};

struct Args { const float* in[17]; float* out; unsigned char* ws; int ph_lo, ph_hi; };
enum { I_X = 0, I_MIXNW, I_WIN, I_HGLB, I_HGNW, I_CONVW, I_CONVB, I_WA, I_BA, I_WX, I_BX, I_LRUA, I_WOUT, I_FFNNW, I_WGU, I_WDN, I_FINW };

DI unsigned f2bf(float f) { unsigned u = __builtin_bit_cast(unsigned, f); return (u + 0x7fffu + ((u >> 16) & 1u)) >> 16; }
DI unsigned pk2(float lo, float hi) { return f2bf(lo) | (f2bf(hi) << 16); }
DI void p0_transpose_item(const float* W, int K, int N, bf16_t* WT, int kb, int n0, int dst_n0, const float* kscale, LAS float* scr, int lane) {
    const int k0 = 64 * kb;
#pragma unroll 8
    for (int i = 0; i < 32; ++i) { const int kk = 2 * i + (lane >> 5); float w = W[(size_t)(k0 + kk) * N + n0 + (lane & 31)]; if (kscale) w *= kscale[k0 + kk]; scr[kk * 33 + (lane & 31)] = w; }
    asm volatile("s_waitcnt lgkmcnt(0)" ::: "memory");
    const int c = lane & 7;
#pragma unroll
    for (int j = 0; j < 4; ++j) { const int n = (lane >> 3) + 8 * j; const LAS float* s = scr + (8 * c) * 33 + n;
        u32x4 o; o.x = pk2(s[0 * 33], s[1 * 33]); o.y = pk2(s[2 * 33], s[3 * 33]); o.z = pk2(s[4 * 33], s[5 * 33]); o.w = pk2(s[6 * 33], s[7 * 33]);
        *(u32x4*)(WT + (size_t)(dst_n0 + n) * K + k0 + 8 * c) = o; }
    asm volatile("s_waitcnt lgkmcnt(0)" ::: "memory");
}
DI void p0_prologue(const Args& a, LAS unsigned char* lds, int wave, int lane) {
    LAS float* scr = (LAS float*)(lds + wave * 16384);
    const int gw = blockIdx.x * 8 + wave, NGW = gridDim.x * 8;
    unsigned char* ws = a.ws;
    constexpr int I_IN = (DM / 64) * (DIN / 32), I_OUT = (DM / 64) * (DM / 32), I_GU = (DM / 64) * (NGU / 32), I_DN = (DFF / 64) * (DM / 32);
    for (int it = gw; it < I_IN + I_OUT + I_GU + I_DN; it += NGW) {
        int r = it;
        if (r < I_IN) { const int nblk = DIN / 32, kb = r / nblk, n0 = 32 * (r % nblk); int d;
            if (n0 < 512) d = 256 * (n0 >> 7) + (n0 & 127); else if (n0 < 1024) { const int x = n0 - 512; d = 256 * (x >> 7) + 128 + (x & 127); } else d = n0;
            p0_transpose_item(a.in[I_WIN], DM, DIN, (bf16_t*)(ws + WS_WIN), kb, n0, d, nullptr, scr, lane); continue; }
        r -= I_IN;
        if (r < I_OUT) { const int nblk = DM / 32, kb = r / nblk, n0 = 32 * (r % nblk);
            p0_transpose_item(a.in[I_WOUT], DM, DM, (bf16_t*)(ws + WS_WOUT), kb, n0, n0, nullptr, scr, lane); continue; }
        r -= I_OUT;
        if (r < I_GU) { const int nblk = NGU / 32, kb = r / nblk, n0 = 32 * (r % nblk); int d;
            if (n0 < DFF) d = 256 * (n0 >> 7) + (n0 & 127); else { const int x = n0 - DFF; d = 256 * (x >> 7) + 128 + (x & 127); }
            p0_transpose_item(a.in[I_WGU], DM, NGU, (bf16_t*)(ws + WS_WGU), kb, n0, d, a.in[I_FFNNW], scr, lane); continue; }
        r -= I_GU;
        { const int nblk = DM / 32, kb = r / nblk, n0 = 32 * (r % nblk);
            p0_transpose_item(a.in[I_WDN], DFF, DM, (bf16_t*)(ws + WS_WDN), kb, n0, n0, nullptr, scr, lane); }
    }
    const float* x = a.in[I_X]; const float* nw = a.in[I_MIXNW]; bf16_t* XN = (bf16_t*)(ws + WS_XN);
    f32x4 w4[4];
#pragma unroll
    for (int j = 0; j < 4; ++j) w4[j] = ((const f32x4*)nw)[lane + 64 * j];
    for (int m0 = gw; m0 < M; m0 += 4 * NGW) {
        f32x4 v[4][4]; float s[4];
#pragma unroll
        for (int k = 0; k < 4; ++k) { const int m = m0 + k * NGW; const f32x4* xr = (const f32x4*)(x + (size_t)(m < M ? m : m0) * DM) + lane; s[k] = 0.f;
#pragma unroll
            for (int j = 0; j < 4; ++j) { v[k][j] = xr[64 * j]; s[k] += (v[k][j][0] * v[k][j][0] + v[k][j][1] * v[k][j][1]) + (v[k][j][2] * v[k][j][2] + v[k][j][3] * v[k][j][3]); } }
#pragma unroll
        for (int k = 0; k < 4; ++k) { const int m = m0 + k * NGW; if (m >= M) break;
            const float rstd = __builtin_amdgcn_rsqf(wave_sum(s[k]) * (1.f / DM) + EPS);
            u32x2* o8 = (u32x2*)(XN + (size_t)m * DM) + lane;
#pragma unroll
            for (int j = 0; j < 4; ++j) { const f32x4 y = v[k][j] * rstd * w4[j]; o8[64 * j] = (u32x2){cvt_pk_bf16(y[0], y[1]), cvt_pk_bf16(y[2], y[3])}; } }
    }
}

#define MFMA16(a, b, c) __builtin_amdgcn_mfma_f32_16x16x32_bf16((a), (b), (c), 0, 0, 0)
template <bool PC>
DI void hgrn_unit(LAS unsigned char* lds, const Args& a, int bh, int sc, int tid, int wid, int lane) {
    unsigned char* ws = a.ws;
    const bf16_t* QD = (const bf16_t*)(ws + WS_QD); const bf16_t* KD = (const bf16_t*)(ws + WS_KD); const bf16_t* KS = (const bf16_t*)(ws + WS_KS);
    const bf16_t* VV = (const bf16_t*)(ws + WS_VV); const bf16_t* GS = (const bf16_t*)(ws + WS_GS); bf16_t* MIXED = (bf16_t*)(ws + WS_MIXED);
    const float* BL = (const float*)(ws + WS_BL); float* SA = (float*)(ws + WS_SA); float* BLS = (float*)(ws + WS_BLS);
    const int b = bh >> 2, h = bh & 3, colb = h * 128, r = lane & 15, q = lane >> 4;
    LAS bf16_t* Qd = (LAS bf16_t*)lds; LAS bf16_t* Kd = (LAS bf16_t*)(lds + 8704); LAS bf16_t* Kst = (LAS bf16_t*)(lds + 17408); LAS bf16_t* Vt = (LAS bf16_t*)(lds + 27648);
    LAS bf16_t* St = (LAS bf16_t*)(lds + 37888); LAS float* RS = (LAS float*)(lds + 72704);
    const size_t row_base = (size_t)b * SEQ + (size_t)sc * 512;
    f32x4 S[8];
#pragma unroll
    for (int kb = 0; kb < 8; ++kb) S[kb] = (f32x4){0.f, 0.f, 0.f, 0.f};
    if (PC) {
        for (int sp = 0; sp < sc; ++sp) {
            const float* sa = SA + ((size_t)(bh * 8 + sp) * 8 + wid) * 2048; const float* bs = BLS + (size_t)(bh * 8 + sp) * 128;
#pragma unroll
            for (int kb = 0; kb < 8; ++kb) { const f32x4 d = *(const f32x4*)(bs + 16 * kb + 4 * q); const f32x4 v = *(const f32x4*)(sa + (kb * 64 + lane) * 4);
                S[kb] = (f32x4){S[kb][0] * fexp(d[0]) + v[0], S[kb][1] * fexp(d[1]) + v[1], S[kb][2] * fexp(d[2]) + v[2], S[kb][3] * fexp(d[3]) + v[3]}; }
        }
#pragma unroll
        for (int kb = 0; kb < 8; ++kb) *(LAS u32x2*)(St + (16 * wid + r) * 136 + 16 * kb + 4 * q) = (u32x2){cvt_pk_bf16(S[kb][0], S[kb][1]), cvt_pk_bf16(S[kb][2], S[kb][3])};
    }
    float blsum = 0.f;
    const int lr = tid & 31, lc = tid >> 5;
    u32x4 gq, gk, gs, gv; f32x4 dkn[8]; u32x2 g2n[2]; float bln = 0.f;
    const float* blbase = BL + (row_base >> 5) * 512 + colb;
    { const size_t off = (row_base + lr) * 512 + colb + lc * 8;
      if (PC) { gq = *(const u32x4*)(QD + off); gk = *(const u32x4*)(KD + off); }
      gs = *(const u32x4*)(KS + off); gv = *(const u32x4*)(VV + off);
#pragma unroll
      for (int kb = 0; kb < 8; ++kb) dkn[kb] = *(const f32x4*)(blbase + 16 * kb + 4 * q);
      if (PC) {
#pragma unroll
          for (int tb = 0; tb < 2; ++tb) g2n[tb] = *(const u32x2*)(GS + (row_base + 16 * tb + r) * 512 + colb + 16 * wid + 4 * q);
      } else if (tid < 128) bln = blbase[tid]; }
    f32x4 nwv = (f32x4){0.f, 0.f, 0.f, 0.f};
    if (PC) nwv = *(const f32x4*)(a.in[I_HGNW] + 16 * wid + 4 * q);
    for (int c = 0; c < 16; ++c) {
        __syncthreads();
        if (PC) { *(LAS u32x4*)(Qd + lr * 136 + lc * 8) = gq; *(LAS u32x4*)(Kd + lr * 136 + lc * 8) = gk; }
#pragma unroll
        for (int j = 0; j < 4; ++j) {
            Kst[(lc * 8 + 2 * j) * 40 + lr] = (bf16_t)(gs[j] & 0xffffu); Kst[(lc * 8 + 2 * j + 1) * 40 + lr] = (bf16_t)(gs[j] >> 16);
            Vt[(lc * 8 + 2 * j) * 40 + lr] = (bf16_t)(gv[j] & 0xffffu); Vt[(lc * 8 + 2 * j + 1) * 40 + lr] = (bf16_t)(gv[j] >> 16);
        }
        f32x4 dk[8]; u32x2 g2c[2];
#pragma unroll
        for (int kb = 0; kb < 8; ++kb) dk[kb] = (f32x4){fexp(dkn[kb][0]), fexp(dkn[kb][1]), fexp(dkn[kb][2]), fexp(dkn[kb][3])};
        g2c[0] = g2n[0]; g2c[1] = g2n[1];
        if (!PC) blsum += bln;
        __syncthreads();
        if (c + 1 < 16) { const size_t off = (row_base + (c + 1) * 32 + lr) * 512 + colb + lc * 8;
            if (PC) { gq = *(const u32x4*)(QD + off); gk = *(const u32x4*)(KD + off); }
            gs = *(const u32x4*)(KS + off); gv = *(const u32x4*)(VV + off);
            const float* blp = blbase + (size_t)(c + 1) * 512;
#pragma unroll
            for (int kb = 0; kb < 8; ++kb) dkn[kb] = *(const f32x4*)(blp + 16 * kb + 4 * q);
            if (PC) {
#pragma unroll
                for (int tb = 0; tb < 2; ++tb) g2n[tb] = *(const u32x2*)(GS + (row_base + (c + 1) * 32 + 16 * tb + r) * 512 + colb + 16 * wid + 4 * q);
            } else if (tid < 128) bln = blp[tid]; }
        f32x4 o[2];
        if (PC) {
            bf16x8 qf[2][4];
#pragma unroll
            for (int tb = 0; tb < 2; ++tb)
#pragma unroll
                for (int ks = 0; ks < 4; ++ks) qf[tb][ks] = *(const LAS bf16x8*)(Qd + (16 * tb + r) * 136 + 32 * ks + 8 * q);
            f32x4 p00 = (f32x4){0.f, 0.f, 0.f, 0.f}, p01 = p00, p11 = p00;
#pragma unroll
            for (int ks = 0; ks < 4; ++ks) {
                const bf16x8 a0 = *(const LAS bf16x8*)(Kd + r * 136 + 32 * ks + 8 * q), a1 = *(const LAS bf16x8*)(Kd + (16 + r) * 136 + 32 * ks + 8 * q);
                p00 = MFMA16(a0, qf[0][ks], p00); p01 = MFMA16(a0, qf[1][ks], p01); p11 = MFMA16(a1, qf[1][ks], p11);
            }
#pragma unroll
            for (int i = 0; i < 4; ++i) if (r < 4 * q + i) { p00[i] = 0.f; p11[i] = 0.f; }
            u32x4 b0w = (u32x4){cvt_pk_bf16(p00[0], p00[1]), cvt_pk_bf16(p00[2], p00[3]), 0u, 0u};
            u32x4 b1w = (u32x4){cvt_pk_bf16(p01[0], p01[1]), cvt_pk_bf16(p01[2], p01[3]), cvt_pk_bf16(p11[0], p11[1]), cvt_pk_bf16(p11[2], p11[3])};
            const bf16x8 pb0 = __builtin_bit_cast(bf16x8, b0w), pb1 = __builtin_bit_cast(bf16x8, b1w);
            const u32x2 v0 = *(const LAS u32x2*)(Vt + (16 * wid + r) * 40 + 4 * q), v1 = *(const LAS u32x2*)(Vt + (16 * wid + r) * 40 + 16 + 4 * q);
            const bf16x8 av = __builtin_bit_cast(bf16x8, (u32x4){v0[0], v0[1], v1[0], v1[1]});
            o[0] = MFMA16(av, pb0, ((f32x4){0.f, 0.f, 0.f, 0.f})); o[1] = MFMA16(av, pb1, ((f32x4){0.f, 0.f, 0.f, 0.f}));
#pragma unroll
            for (int ks = 0; ks < 4; ++ks) { const bf16x8 sa = *(const LAS bf16x8*)(St + (16 * wid + r) * 136 + 32 * ks + 8 * q);
                o[0] = MFMA16(sa, qf[0][ks], o[0]); o[1] = MFMA16(sa, qf[1][ks], o[1]); }
#pragma unroll
            for (int tb = 0; tb < 2; ++tb) { float ss = (o[tb][0] * o[tb][0] + o[tb][1] * o[tb][1]) + (o[tb][2] * o[tb][2] + o[tb][3] * o[tb][3]);
                ss += __shfl_xor(ss, 16); ss += __shfl_xor(ss, 32); if (q == 0) RS[wid * 32 + 16 * tb + r] = ss; }
        }
        { const bf16x8 bv = *(const LAS bf16x8*)(Vt + (16 * wid + r) * 40 + 8 * q);
#pragma unroll
          for (int kb = 0; kb < 8; ++kb) { const bf16x8 ak = *(const LAS bf16x8*)(Kst + (16 * kb + r) * 40 + 8 * q);
              const f32x4 sd = S[kb] * dk[kb];
              S[kb] = MFMA16(ak, bv, sd); }
          if (PC) {
#pragma unroll
              for (int kb = 0; kb < 8; ++kb) *(LAS u32x2*)(St + (16 * wid + r) * 136 + 16 * kb + 4 * q) = (u32x2){cvt_pk_bf16(S[kb][0], S[kb][1]), cvt_pk_bf16(S[kb][2], S[kb][3])};
          } }
        if (PC) {
            __syncthreads();
#pragma unroll
            for (int tb = 0; tb < 2; ++tb) { const int t = 16 * tb + r; float tot = 0.f;
#pragma unroll
                for (int w = 0; w < 8; ++w) tot += RS[w * 32 + t];
                const float rstd = __builtin_amdgcn_rsqf(tot * (1.f / 128.f) + EPS);
                const size_t row = row_base + c * 32 + t;
                const u32x2 g2 = g2c[tb];
                const float y0 = o[tb][0] * rstd * nwv[0] * bflo(g2[0]), y1 = o[tb][1] * rstd * nwv[1] * bfhi(g2[0]), y2 = o[tb][2] * rstd * nwv[2] * bflo(g2[1]), y3 = o[tb][3] * rstd * nwv[3] * bfhi(g2[1]);
                *(u32x2*)(MIXED + row * DM + colb + 16 * wid + 4 * q) = (u32x2){cvt_pk_bf16(y0, y1), cvt_pk_bf16(y2, y3)}; }
        }
    }
    if (!PC) {
        float* sa = SA + ((size_t)(bh * 8 + sc) * 8 + wid) * 2048;
#pragma unroll
        for (int kb = 0; kb < 8; ++kb) *(f32x4*)(sa + (kb * 64 + lane) * 4) = S[kb];
        if (tid < 128) BLS[(size_t)(bh * 8 + sc) * 128 + tid] = blsum;
    }
    __syncthreads();
}

template <bool PC>
DI void lru_unit(LAS unsigned char* lds, const Args& a, int b, int n, int seg, int tid, int wid, int lane) {
    unsigned char* ws = a.ws;
    const bf16_t* LX = (const bf16_t*)(ws + WS_LX); const bf16_t* LG = (const bf16_t*)(ws + WS_LG); bf16_t* MIXED = (bf16_t*)(ws + WS_MIXED); float* LRT = (float*)(ws + WS_LRT);
    LAS bf16_t* Xs = (LAS bf16_t*)lds; LAS bf16_t* XCb = (LAS bf16_t*)(lds + 19456); LAS float* XCf = (LAS float*)(lds + 37888);
    const int r = lane & 15, q = lane >> 4, eb = wid & 3, th = wid >> 2, ch = n * 64 + eb * 16 + r;
    bf16x8 wa_f[2], wx_f[2];
    { const float* wa = a.in[I_WA] + (size_t)n * 4096; const float* wx = a.in[I_WX] + (size_t)n * 4096;
#pragma unroll
      for (int ks = 0; ks < 2; ++ks) { unsigned pa[4], px[4];
#pragma unroll
          for (int j2 = 0; j2 < 4; ++j2) { const int d = 32 * ks + 8 * q + 2 * j2;
              pa[j2] = pk2(wa[d * 64 + eb * 16 + r], wa[(d + 1) * 64 + eb * 16 + r]); px[j2] = pk2(wx[d * 64 + eb * 16 + r], wx[(d + 1) * 64 + eb * 16 + r]); }
          wa_f[ks] = __builtin_bit_cast(bf16x8, (u32x4){pa[0], pa[1], pa[2], pa[3]}); wx_f[ks] = __builtin_bit_cast(bf16x8, (u32x4){px[0], px[1], px[2], px[3]}); } }
    const float ba = a.in[I_BA][ch], bx = a.in[I_BX][ch];
    const float ap = a.in[I_LRUA][ch];
    const float sp8 = 8.f * (ap > 15.f ? fexp(-ap) : __logf(1.f + fexp(-ap)));
    const int seg2 = seg * 2 + th;
    float carry = 0.f, Atot = 1.f, Btot = 0.f;
    if (PC) { for (int s = 0; s < seg2; ++s) { const f32x2 ab = *(const f32x2*)(LRT + ((size_t)(b * 16 + s) * 512 + ch) * 2); carry = ab[0] * carry + ab[1]; } }
    const int cc = tid & 7;
    const float* cw = a.in[I_CONVW] + n * 64 + cc * 8; const float* cb = a.in[I_CONVB] + n * 64 + cc * 8;
    LAS bf16_t* Gs = (LAS bf16_t*)(lds + 72704);
    u32x4 xp[3], gp[2];
    const size_t seqb = (size_t)b * SEQ;
#define LRU_PREFETCH(jj) do { _Pragma("unroll") for (int k = 0; k < 3; ++k) { const int it = tid + 512 * k; xp[k] = (u32x4){0u, 0u, 0u, 0u}; \
            if (it < 1072) { const int th2 = it >= 536, rem = it - th2 * 536, row = rem >> 3, c8 = rem & 7; const int tok = seg * 512 + th2 * 256 + (jj) * 64 + row - 3; \
                if (tok >= 0) xp[k] = *(const u32x4*)(LX + (seqb + tok) * 512 + n * 64 + c8 * 8); } } \
        if (PC) { _Pragma("unroll") for (int k = 0; k < 2; ++k) { const int it = tid + 512 * k, th2 = it >> 9, t = (it >> 3) & 63; \
            gp[k] = *(const u32x4*)(LG + (seqb + seg * 512 + th2 * 256 + (jj) * 64 + t) * 512 + n * 64 + cc * 8); } } } while (0)
    LRU_PREFETCH(0);
    for (int j = 0; j < 4; ++j) {
        __syncthreads();
#pragma unroll
        for (int k = 0; k < 3; ++k) { const int it = tid + 512 * k;
            if (it < 1072) { const int th2 = it >= 536, rem = it - th2 * 536, row = rem >> 3, c8 = rem & 7; *(LAS u32x4*)(Xs + (th2 * 67 + row) * 72 + c8 * 8) = xp[k]; } }
        if (PC) {
#pragma unroll
            for (int k = 0; k < 2; ++k) { const int it = tid + 512 * k, th2 = it >> 9, t = (it >> 3) & 63; *(LAS u32x4*)(Gs + (th2 * 64 + t) * 72 + cc * 8) = gp[k]; } }
        __syncthreads();
        if (j + 1 < 4) LRU_PREFETCH(j + 1);
#pragma unroll
        for (int k = 0; k < 2; ++k) {
            const int it = tid + 512 * k, th2 = it >> 9, t = (it >> 3) & 63;
            float xc[8];
#pragma unroll
            for (int c = 0; c < 8; ++c) xc[c] = cb[c];
#pragma unroll
            for (int tap = 0; tap < 4; ++tap) { const u32x4 xv = *(const LAS u32x4*)(Xs + (th2 * 67 + t + tap) * 72 + cc * 8);
                const f32x4 w0 = *(const f32x4*)(cw + tap * 512), w1 = *(const f32x4*)(cw + tap * 512 + 4);
                xc[0] += bflo(xv[0]) * w0[0]; xc[1] += bfhi(xv[0]) * w0[1]; xc[2] += bflo(xv[1]) * w0[2]; xc[3] += bfhi(xv[1]) * w0[3];
                xc[4] += bflo(xv[2]) * w1[0]; xc[5] += bfhi(xv[2]) * w1[1]; xc[6] += bflo(xv[3]) * w1[2]; xc[7] += bfhi(xv[3]) * w1[3]; }
            *(LAS u32x4*)(XCb + (th2 * 64 + t) * 72 + cc * 8) = (u32x4){cvt_pk_bf16(xc[0], xc[1]), cvt_pk_bf16(xc[2], xc[3]), cvt_pk_bf16(xc[4], xc[5]), cvt_pk_bf16(xc[6], xc[7])};
            *(LAS f32x4*)(XCf + (th2 * 64 + t) * 68 + cc * 8) = (f32x4){xc[0], xc[1], xc[2], xc[3]};
            *(LAS f32x4*)(XCf + (th2 * 64 + t) * 68 + cc * 8 + 4) = (f32x4){xc[4], xc[5], xc[6], xc[7]};
        }
        __syncthreads();
#pragma unroll 2
        for (int tb = 0; tb < 4; ++tb) {
            f32x4 R = (f32x4){0.f, 0.f, 0.f, 0.f}, I = R;
#pragma unroll
            for (int ks = 0; ks < 2; ++ks) { const bf16x8 af = *(const LAS bf16x8*)(XCb + (th * 64 + 16 * tb + r) * 72 + 32 * ks + 8 * q);
                R = MFMA16(af, wa_f[ks], R); I = MFMA16(af, wx_f[ks], I); }
            float av[4], bv[4];
            const int trow = th * 64 + 16 * tb + 4 * q;
#pragma unroll
            for (int i = 0; i < 4; ++i) {
                const float xcv = XCf[(trow + i) * 68 + eb * 16 + r];
                const float rg = sigm(R[i] + ba), ig = sigm(I[i] + bx);
                const float aa = fexp(-sp8 * rg);
                av[i] = aa; bv[i] = __builtin_sqrtf(fmaxf(1.f - aa * aa, 0.f)) * ig * xcv;
            }
            float Al = av[0], Bl = bv[0];
#pragma unroll
            for (int i = 1; i < 4; ++i) { Bl = av[i] * Bl + bv[i]; Al *= av[i]; }
            float Ai = Al, Bi = Bl;
            { const float Ap = __shfl_up(Ai, 16), Bp = __shfl_up(Bi, 16); if (q >= 1) { Bi = Ai * Bp + Bi; Ai = Ai * Ap; } }
            { const float Ap = __shfl_up(Ai, 32), Bp = __shfl_up(Bi, 32); if (q >= 2) { Bi = Ai * Bp + Bi; Ai = Ai * Ap; } }
            float Ae = __shfl_up(Ai, 16), Be = __shfl_up(Bi, 16); if (q == 0) { Ae = 1.f; Be = 0.f; }
            const float A3 = __shfl(Ai, r + 48), B3 = __shfl(Bi, r + 48);
            if (PC) {
                float hcur = Ae * carry + Be;
#pragma unroll
                for (int i = 0; i < 4; ++i) { hcur = av[i] * hcur + bv[i];
                    LAS bf16_t* gpt = Gs + (trow + i) * 72 + eb * 16 + r;
                    *gpt = (bf16_t)f2bf(hcur * bf2f(*gpt)); }
                carry = A3 * carry + B3;
            } else { Btot = A3 * Btot + B3; Atot *= A3; }
        }
        if (PC) {
            __syncthreads();
#pragma unroll
            for (int k = 0; k < 2; ++k) { const int it = tid + 512 * k, th2 = it >> 9, t = (it >> 3) & 63;
                *(u32x4*)(MIXED + (seqb + seg * 512 + th2 * 256 + j * 64 + t) * DM + 512 + n * 64 + cc * 8) = *(const LAS u32x4*)(Gs + (th2 * 64 + t) * 72 + cc * 8); }
        }
    }
#undef LRU_PREFETCH
    if (!PC) { if (q == 0) *(f32x2*)(LRT + ((size_t)(b * 16 + seg2) * 512 + ch) * 2) = (f32x2){Atot, Btot}; }
    __syncthreads();
}

#define XB_TMO      128
#define XB_XCNT(j)  (256  + 64 * (j))
#define XB_XSUB(j)  (1280 + 64 * (j))
#define XB_XGEN(j)  (2304 + 64 * (j))
#define XB_TOP      3328
#define XB_TOPGEN   3392
#define XCD_BAR_WORDS 3456
#define XB_SPIN_CAP (1u << 18)

__device__ __forceinline__ unsigned xb_ld(unsigned* p)              { return __hip_atomic_load(p, __ATOMIC_RELAXED, __HIP_MEMORY_SCOPE_AGENT); }
__device__ __forceinline__ unsigned xb_add(unsigned* p, unsigned v) { return __hip_atomic_fetch_add(p, v, __ATOMIC_RELAXED, __HIP_MEMORY_SCOPE_AGENT); }
__device__ __forceinline__ unsigned xb_xcc_id() { return (unsigned)__builtin_amdgcn_s_getreg((3 << 11) | 20) & 0xFu; }
#define XB_SPIN(cond, bar) do { unsigned _sp = 0; while (cond) { __builtin_amdgcn_s_sleep(1); \
    if ((++_sp & 255u) == 0u) { if (xb_ld(&(bar)[XB_TMO])) break; if (_sp > XB_SPIN_CAP) { atomicAdd(&(bar)[XB_TMO], 1u); break; } } } } while (0)

struct XcdBarrier {
    unsigned* bar; unsigned x;
    volatile LAS unsigned* st;
};

__device__ __forceinline__ XcdBarrier xcd_barrier_post(unsigned* bar, volatile LAS unsigned* st) {
    XcdBarrier b; b.bar = bar; b.x = xb_xcc_id(); b.st = st;
    if (threadIdx.x == 0) (void)xb_add(&bar[XB_XCNT(b.x)], 1u);
    return b;
}
__device__ __forceinline__ void xcd_barrier_complete(unsigned* bar, unsigned x, unsigned& nloc, unsigned& nx) {
    const unsigned G = gridDim.x * gridDim.y * gridDim.z;
    unsigned sum, cnt, mine, sp = 0u;
    for (;;) {
        sum = 0u; cnt = 0u; mine = 0u;
#pragma unroll
        for (unsigned j = 0; j < 16; ++j) { const unsigned c = xb_ld(&bar[XB_XCNT(j)]); sum += c; cnt += (c > 0u) ? 1u : 0u; mine = (j == x) ? c : mine; }
        if (sum == G) break;
        __builtin_amdgcn_s_sleep(1);
        if ((++sp & 255u) == 0u) { if (xb_ld(&bar[XB_TMO])) break; if (sp > XB_SPIN_CAP) { atomicAdd(&bar[XB_TMO], 1u); break; } }
    }
    nloc = mine > 0u ? mine : 1u; nx = cnt > 0u ? cnt : 1u;
}

__device__ __forceinline__ void xcd_barrier(const XcdBarrier& b) {
    asm volatile("s_waitcnt vmcnt(0)" ::: "memory");
    __syncthreads();
    if (threadIdx.x == 0) {
        unsigned* bar = b.bar;
        __builtin_amdgcn_s_waitcnt(0);
        unsigned nloc = b.st[0], nx = b.st[1];
        if (nloc == 0u) { xcd_barrier_complete(bar, b.x, nloc, nx); b.st[0] = nloc; b.st[1] = nx; }
        const unsigned old = xb_add(&bar[XB_XSUB(b.x)], 1u);
        const unsigned gen = old / nloc;
        if (old + 1u == (gen + 1u) * nloc) {
            __builtin_amdgcn_fence(__ATOMIC_RELEASE, "agent");
            asm volatile("s_waitcnt vmcnt(0)" ::: "memory");
            const unsigned og = xb_add(&bar[XB_TOP], 1u);
            const unsigned tg = og / nx;
            if (og + 1u == (tg + 1u) * nx) xb_add(&bar[XB_TOPGEN], 1u);
            else XB_SPIN(xb_ld(&bar[XB_TOPGEN]) == tg, bar);
            __builtin_amdgcn_fence(__ATOMIC_ACQUIRE, "agent");
            xb_add(&bar[XB_XGEN(b.x)], 1u);
            asm volatile("s_waitcnt vmcnt(0)" ::: "memory");
        } else {
            XB_SPIN(xb_ld(&bar[XB_XGEN(b.x)]) == gen, bar);
            __builtin_amdgcn_fence(__ATOMIC_ACQUIRE, "agent");
            asm volatile("s_waitcnt vmcnt(0)" ::: "memory");
        }
    }
    __syncthreads();
}

__global__ void __launch_bounds__(512, 2) fwd_megakernel(Args a) {
    extern __shared__ __attribute__((aligned(16))) unsigned char lds_raw[];
    LAS unsigned char* lds = (LAS unsigned char*)lds_raw;
    cg::grid_group grid = cg::this_grid();
    const int tid = threadIdx.x, lane = tid & 63, wid = __builtin_amdgcn_readfirstlane(tid >> 6);
    const int lo = a.ph_lo, hi = a.ph_hi, G = gridDim.x;
    unsigned char* ws = a.ws;
#define IN(k) (lo <= (k) && (k) < hi)
#define SEAM(k) do { if (IN(k) && IN((k) + 1)) xcd_barrier(bar); } while (0)
    volatile LAS unsigned* misc = (volatile LAS unsigned*)(lds + LDS_MISC_OFF);
    if (tid < 16) misc[tid] = 0u;
    __syncthreads();
    XcdBarrier bar = xcd_barrier_post((unsigned*)(ws + WS_CTL), misc);
    if (a.ph_lo < 0) grid.sync();
    if (IN(0)) { p0_prologue(a, lds, wid, lane); }
    SEAM(0);
    if (IN(1)) {
        pg8::Gemm g{(const bf16_t*)(ws + WS_XN), (const bf16_t*)(ws + WS_WIN), M, DIN, DM}; pg8::StaticOrder S; S.init(M, DIN, G, (int)blockIdx.x);
        EpiG1 E{(bf16_t*)(ws + WS_QD), (bf16_t*)(ws + WS_KD), (bf16_t*)(ws + WS_KS), (bf16_t*)(ws + WS_VV), (bf16_t*)(ws + WS_GS), (bf16_t*)(ws + WS_LX), (bf16_t*)(ws + WS_LG), (float*)(ws + WS_BL), a.in[I_HGLB]};
        pg8::gemm_phase<EpiG1, true>(lds, g, S, E);
    }
    SEAM(1);
    if (IN(2)) {
        for (int u = blockIdx.x; u < 224; u += G) hgrn_unit<false>(lds, a, u / 7, u % 7, tid, wid, lane);
        for (int u = blockIdx.x; u < 512; u += G) lru_unit<false>(lds, a, u >> 6, (u >> 3) & 7, u & 7, tid, wid, lane);
    }
    SEAM(2);
    if (IN(3)) {
        for (int u = blockIdx.x; u < 256; u += G) hgrn_unit<true>(lds, a, u >> 3, u & 7, tid, wid, lane);
        for (int u = blockIdx.x; u < 512; u += G) lru_unit<true>(lds, a, u >> 6, (u >> 3) & 7, u & 7, tid, wid, lane);
    }
    SEAM(3);
    if (IN(4)) {
        pg8::Gemm g{(const bf16_t*)(ws + WS_MIXED), (const bf16_t*)(ws + WS_WOUT), M, DM, DM}; pg8::StaticOrder S; S.init(M, DM, G, (int)blockIdx.x);
        EpiRes<true> E{a.in[I_X], nullptr, nullptr, (bf16_t*)(ws + WS_H1B), (float*)(ws + WS_PART1)};
        pg8::gemm_phase<EpiRes<true>, true>(lds, g, S, E);
    }
    SEAM(4);
    if (IN(5)) {
        pg8::Gemm g{(const bf16_t*)(ws + WS_H1B), (const bf16_t*)(ws + WS_WGU), M, NGU, DM}; pg8::StaticOrder S; S.init(M, NGU, G, (int)blockIdx.x);
        EpiG3 E{(const float*)(ws + WS_PART1), (bf16_t*)(ws + WS_ACT)};
        pg8::gemm_phase<EpiG3, true>(lds, g, S, E);
    }
    SEAM(5);
    if (IN(6)) {
        pg8::Gemm g{(const bf16_t*)(ws + WS_ACT), (const bf16_t*)(ws + WS_WDN), M, DM, DFF}; pg8::StaticOrder S; S.init(M, DM, G, (int)blockIdx.x);
        EpiRes<false> E{nullptr, (const bf16_t*)(ws + WS_H1B), a.out, nullptr, (float*)(ws + WS_PART2)};
        pg8::gemm_phase<EpiRes<false>, true>(lds, g, S, E);
    }
    SEAM(6);
    if (IN(7)) {
        const float* part = (const float*)(ws + WS_PART2); const float* fw = a.in[I_FINW];
        f32x4 w4[4];
#pragma unroll
        for (int j = 0; j < 4; ++j) w4[j] = ((const f32x4*)fw)[lane + 64 * j];
        for (int m0 = blockIdx.x * 8 + wid; m0 < M; m0 += 4 * G * 8) {
            f32x4 v[4][4]; float p[4];
#pragma unroll
            for (int k = 0; k < 4; ++k) { const int m = (m0 + k * G * 8) < M ? (m0 + k * G * 8) : m0; p[k] = lane < 16 ? part[(size_t)m * 16 + lane] : 0.f;
                const f32x4* xr = (const f32x4*)(a.out + (size_t)m * DM) + lane;
#pragma unroll
                for (int j = 0; j < 4; ++j) v[k][j] = xr[64 * j]; }
#pragma unroll
            for (int k = 0; k < 4; ++k) { const int m = m0 + k * G * 8; if (m >= M) break;
                const float rstd = __builtin_amdgcn_rsqf(wave_sum(p[k]) * (1.f / DM) + EPS);
                f32x4* xr = (f32x4*)(a.out + (size_t)m * DM) + lane;
#pragma unroll
                for (int j = 0; j < 4; ++j) xr[64 * j] = v[k][j] * rstd * w4[j]; }
        }
    }
#undef IN
#undef SEAM
}

extern "C" void kernel_launch(void* const* d_in, const int* in_sizes, int n_in, void* d_out, int out_size, void* d_ws, size_t ws_size, hipStream_t stream) {
    static int grid = 0;
    if (grid == 0) {
        if (n_in != 17 || out_size != M * DM || ws_size < WS_END) { fprintf(stderr, "kernel_launch: unexpected shapes (n_in %d, out %d, ws %zu)\n", n_in, out_size, ws_size); grid = -1; return; }
        int dev = 0, cus = 0, per_cu = 0;
        (void)hipGetDevice(&dev); (void)hipDeviceGetAttribute(&cus, hipDeviceAttributeMultiprocessorCount, dev);
        if (hipFuncSetAttribute((const void*)fwd_megakernel, hipFuncAttributeMaxDynamicSharedMemorySize, LDS_BYTES) != hipSuccess) { fprintf(stderr, "kernel_launch: hipFuncSetAttribute failed\n"); grid = -1; return; }
        if (hipOccupancyMaxActiveBlocksPerMultiprocessor(&per_cu, (const void*)fwd_megakernel, 512, LDS_BYTES) != hipSuccess || per_cu < 1) { fprintf(stderr, "kernel_launch: occupancy query says %d blocks/CU\n", per_cu); per_cu = 1; }
        (void)hipGetLastError();
        grid = cus * (per_cu < 1 ? 1 : 1);
        fprintf(stderr, "kernel_launch: grid %d (cus %d, per_cu %d)\n", grid, cus, per_cu);
    }
    if (grid < 0) return;
    if (hipMemsetAsync((char*)d_ws + WS_CTL, 0, CTL_ZERO_BYTES, stream) != hipSuccess) { fprintf(stderr, "kernel_launch: memset failed\n"); return; }
    Args a{};
    for (int i = 0; i < 17; ++i) a.in[i] = (const float*)d_in[i];
    a.out = (float*)d_out; a.ws = (unsigned char*)d_ws;
#if MK_N_LAUNCHES == 1
    a.ph_lo = 0; a.ph_hi = NPH;
    void* args[] = {&a};
    hipError_t e = hipLaunchCooperativeKernel((const void*)fwd_megakernel, dim3(grid), dim3(512), args, LDS_BYTES, stream);
    if (e != hipSuccess) fprintf(stderr, "cooperative launch failed: %s (grid %d)\n", hipGetErrorString(e), grid);
#else
    for (int p = 0; p < NPH; ++p) { a.ph_lo = p; a.ph_hi = p + 1; hipLaunchKernelGGL(fwd_megakernel, dim3(grid), dim3(512), LDS_BYTES, stream, a); }
#endif
}
```
